# Optimizing an MI355X kernel written in HIP

```python
import math
import jax, jax.numpy as jnp
from jax import lax
import numpy as np

D_MODEL = 2048
BATCH = 16
SEQ = 2048
DEPTH = 2

MIX_WIDTH = D_MODEL
HEAD_DIM = 128
SSM_WIDTH = MIX_WIDTH // 4
SSM_GROUP = 16
SSM_GROUPS = SSM_WIDTH // SSM_GROUP
SSM_STATE = 64
ATTN_HEADS = (MIX_WIDTH // 2) // HEAD_DIM
ATTN_KV_HEADS = ATTN_HEADS // 4
ATTN_WIDTH = ATTN_HEADS * HEAD_DIM
KV_WIDTH = ATTN_KV_HEADS * HEAD_DIM
WINDOW = 128
BLOCK = 128
NB_SIDE = -(-WINDOW // BLOCK)
ROPE_THETA = 500000.0
ROPE_DIMS = HEAD_DIM // 4
RET_WIDTH = MIX_WIDTH - SSM_WIDTH - ATTN_WIDTH
RET_HEADS = RET_WIDTH // HEAD_DIM
RET_CHUNK = 128
RET_THETA = 10000.0
EPS = 1e-6

_IN_SIZES = (SSM_WIDTH, SSM_WIDTH,
             ATTN_WIDTH, KV_WIDTH, KV_WIDTH, ATTN_WIDTH,
             RET_WIDTH, RET_WIDTH, RET_WIDTH, RET_WIDTH)
IN_WIDTH = sum(_IN_SIZES)
_IN_SPLITS = tuple(int(s) for s in np.cumsum(_IN_SIZES)[:-1])

kernel_name = 'hybrid_s5_swa_retention_adaln_block'


def rms_norm(x, w):
    xf = x.astype(jnp.float32)
    y = xf * lax.rsqrt(jnp.mean(xf * xf, axis=-1, keepdims=True) + EPS)
    return (y * w.astype(jnp.float32)).astype(x.dtype)


def rotary(x, positions, n_rot, theta):
    half = n_rot // 2
    inv = theta ** (-jnp.arange(half, dtype=jnp.float32) * 2.0 / n_rot)
    ang = positions.astype(jnp.float32)[..., None] * inv
    cos = jnp.cos(ang)[:, :, None, :]
    sin = jnp.sin(ang)[:, :, None, :]
    x1 = x[..., :half].astype(jnp.float32)
    x2 = x[..., half:n_rot].astype(jnp.float32)
    rot = jnp.concatenate([x1 * cos - x2 * sin, x2 * cos + x1 * sin], axis=-1).astype(x.dtype)
    return jnp.concatenate([rot, x[..., n_rot:]], axis=-1)


def _complex_affine_combine(e1, e2):
    a1r, a1i, b1r, b1i = e1
    a2r, a2i, b2r, b2i = e2
    return (a2r * a1r - a2i * a1i,
            a2r * a1i + a2i * a1r,
            a2r * b1r - a2i * b1i + b2r,
            a2r * b1i + a2i * b1r + b2i)


def s5_direction(u, lam_re, lam_im, log_dt, b_re, b_im, c_re, c_im, reverse):
    Bn, L, G, P = u.shape
    N = lam_re.shape[-1]
    f32 = jnp.float32
    dt = jnp.exp(log_dt.astype(f32))[:, None]
    lr = lam_re.astype(f32)
    li = lam_im.astype(f32)
    mag = jnp.exp(lr * dt)
    ang = li * dt
    ab_re = mag * jnp.cos(ang)
    ab_im = mag * jnp.sin(ang)
    nr = ab_re - 1.0
    den = lr * lr + li * li
    f_re = (nr * lr + ab_im * li) / den
    f_im = (ab_im * lr - nr * li) / den
    br = b_re.astype(f32)
    bi = b_im.astype(f32)
    bb_re = f_re[..., None] * br - f_im[..., None] * bi
    bb_im = f_re[..., None] * bi + f_im[..., None] * br
    uf = u.astype(f32)
    bu_re = jnp.einsum('blgp,gnp->blgn', uf, bb_re)
    bu_im = jnp.einsum('blgp,gnp->blgn', uf, bb_im)
    a_re = jnp.broadcast_to(ab_re, (1, L, G, N))
    a_im = jnp.broadcast_to(ab_im, (1, L, G, N))
    _, _, h_re, h_im = lax.associative_scan(
        _complex_affine_combine, (a_re, a_im, bu_re, bu_im), reverse=reverse, axis=1)
    return (jnp.einsum('blgn,gpn->blgp', h_re, c_re.astype(f32))
            - jnp.einsum('blgn,gpn->blgp', h_im, c_im.astype(f32)))


def window_attention(q, k, v, sink):
    Bn, L, H, Dh = q.shape
    Hk = k.shape[2]
    rep = H // Hk
    nb = L // BLOCK
    kw = (2 * NB_SIDE + 1) * BLOCK
    qb = q.reshape(Bn, nb, BLOCK, Hk, rep, Dh)
    pad = ((0, 0), (NB_SIDE * BLOCK, NB_SIDE * BLOCK), (0, 0), (0, 0))
    kp = jnp.pad(k, pad)
    vp = jnp.pad(v, pad)
    kb = jnp.concatenate([kp[:, i * BLOCK:i * BLOCK + L].reshape(Bn, nb, BLOCK, Hk, Dh)
                          for i in range(2 * NB_SIDE + 1)], axis=2)
    vb = jnp.concatenate([vp[:, i * BLOCK:i * BLOCK + L].reshape(Bn, nb, BLOCK, Hk, Dh)
                          for i in range(2 * NB_SIDE + 1)], axis=2)
    qi = jnp.arange(BLOCK)[:, None]
    kj = jnp.arange(kw)[None, :]
    rel = kj - NB_SIDE * BLOCK - qi
    kpos = jnp.arange(nb)[:, None, None] * BLOCK + kj[None] - NB_SIDE * BLOCK
    mask = (jnp.abs(rel)[None] <= WINDOW) & (kpos >= 0) & (kpos < L)
    s = jnp.einsum('bcqgrd,bckgd->bgrcqk', qb, kb).astype(jnp.float32) * (Dh ** -0.5)
    s = jnp.where(mask, s, -1e30)
    sk = sink.astype(jnp.float32).reshape(Hk, rep)[None, :, :, None, None, None]
    m = jnp.maximum(jnp.max(s, axis=-1, keepdims=True), sk)
    p = jnp.exp(s - m)
    p = p / (jnp.sum(p, axis=-1, keepdims=True) + jnp.exp(sk - m))
    o = jnp.einsum('bgrcqk,bckgd->bcqgrd', p.astype(v.dtype), vb)
    return o.reshape(Bn, L, H, Dh)


def bidirectional_retention(q, k, v):
    Bn, L, H, Dh = q.shape
    C = RET_CHUNK
    nc = L // C
    f32 = jnp.float32
    lg = jnp.log1p(-jnp.exp2(-5.0 - jnp.arange(H, dtype=f32)))
    qc = (q * (Dh ** -0.5)).reshape(Bn, nc, C, H, Dh)
    kc = (k * (Dh ** -0.5)).reshape(Bn, nc, C, H, Dh)
    vc = v.reshape(Bn, nc, C, H, Dh)
    idx = jnp.arange(C, dtype=f32)
    dec = jnp.exp(jnp.abs(idx[:, None] - idx[None, :])[None] * lg[:, None, None])
    sc = jnp.einsum('bnihd,bnjhd->bnhij', qc, kc) * dec
    o = jnp.einsum('bnhij,bnjhd->bnihd', sc, vc)
    w_to_end = jnp.exp((C - 1.0 - idx)[:, None] * lg[None, :])
    w_from_start = jnp.exp(idx[:, None] * lg[None, :])
    kv_fwd = jnp.einsum('bnjhd,jh,bnjhe->nbhde', kc, w_to_end, vc)
    kv_bwd = jnp.einsum('bnjhd,jh,bnjhe->nbhde', kc, w_from_start, vc)
    g_chunk = jnp.exp(C * lg)[None, :, None, None]

    def step(state, kv):
        return g_chunk * state + kv, state

    init = jnp.zeros((Bn, H, Dh, Dh), kv_fwd.dtype)
    _, s_past = lax.scan(step, init, kv_fwd)
    _, s_fut = lax.scan(step, init, kv_bwd, reverse=True)
    past_w = jnp.exp((idx + 1.0)[:, None] * lg[None, :])[:, :, None]
    fut_w = jnp.exp((C - idx)[:, None] * lg[None, :])[:, :, None]
    o = (o + jnp.einsum('bnihd,nbhde->bnihe', qc, s_past) * past_w
         + jnp.einsum('bnihd,nbhde->bnihe', qc, s_fut) * fut_w)
    return o.reshape(Bn, L, H, Dh)


def head_group_norm(o, w):
    Bn, L, H, Dh = o.shape
    of = o.astype(jnp.float32)
    mu = jnp.mean(of, axis=-1, keepdims=True)
    var = jnp.mean(jnp.square(of - mu), axis=-1, keepdims=True)
    y = ((of - mu) * lax.rsqrt(var + EPS)).reshape(Bn, L, H * Dh)
    return y * w.astype(jnp.float32)


def setup_inputs(seed: int = 0) -> dict:
    key = jax.random.key(seed)
    ks = jax.random.split(key, 24)
    f32 = jnp.float32
    G, P, N = SSM_GROUPS, SSM_GROUP, SSM_STATE

    def nrm(k, shape, s):
        return s * jax.random.normal(k, shape, f32)

    x = nrm(ks[0], (BATCH, SEQ, D_MODEL), 1.0)
    c = nrm(ks[1], (BATCH, D_MODEL), 1.0)
    offset = jax.random.randint(ks[2], (BATCH, 1), 0, 1024, dtype=jnp.int32)
    positions = offset + jnp.arange(SEQ, dtype=jnp.int32)[None, :]
    norm_w = 1.0 + nrm(ks[3], (DEPTH, D_MODEL), 0.02)
    ada_w = nrm(ks[4], (DEPTH, D_MODEL, 3 * D_MODEL), 0.5 * D_MODEL ** -0.5)
    ada_b = nrm(ks[5], (DEPTH, 3 * D_MODEL), 0.02)
    w_in = nrm(ks[6], (DEPTH, D_MODEL, IN_WIDTH), D_MODEL ** -0.5)
    w_out = nrm(ks[7], (DEPTH, MIX_WIDTH, D_MODEL), MIX_WIDTH ** -0.5)
    n_idx = jnp.arange(N, dtype=f32)
    ssm_lam_re = -0.5 + nrm(ks[8], (DEPTH, 2, G, N), 0.01)
    ssm_lam_im = jnp.pi * n_idx + nrm(ks[9], (DEPTH, 2, G, N), 0.01)
    ssm_log_dt = jax.random.uniform(ks[10], (DEPTH, 2, G), f32, math.log(1e-3), math.log(1e-1))
    ssm_b_re = nrm(ks[11], (DEPTH, 2, G, N, P), (2 * P) ** -0.5)
    ssm_b_im = nrm(ks[12], (DEPTH, 2, G, N, P), (2 * P) ** -0.5)
    ssm_c_re = nrm(ks[13], (DEPTH, 2, G, P, N), 0.5)
    ssm_c_im = nrm(ks[14], (DEPTH, 2, G, P, N), 0.5)
    ssm_d = nrm(ks[15], (DEPTH, SSM_WIDTH), 1.0)
    ssm_glu_w = nrm(ks[16], (DEPTH, SSM_WIDTH, SSM_WIDTH), SSM_WIDTH ** -0.5)
    ssm_glu_b = nrm(ks[17], (DEPTH, SSM_WIDTH), 0.02)
    attn_q_norm = 1.0 + nrm(ks[18], (DEPTH, HEAD_DIM), 0.02)
    attn_k_norm = 1.0 + nrm(ks[19], (DEPTH, HEAD_DIM), 0.02)
    attn_sink = nrm(ks[20], (DEPTH, ATTN_HEADS), 1.0)
    ret_gn_w = 1.0 + nrm(ks[21], (DEPTH, RET_WIDTH), 0.02)
    return {'x': x, 'c': c, 'positions': positions, 'norm_w': norm_w,
            'ada_w': ada_w, 'ada_b': ada_b, 'w_in': w_in, 'w_out': w_out,
            'ssm_lam_re': ssm_lam_re, 'ssm_lam_im': ssm_lam_im, 'ssm_log_dt': ssm_log_dt,
            'ssm_b_re': ssm_b_re, 'ssm_b_im': ssm_b_im, 'ssm_c_re': ssm_c_re,
            'ssm_c_im': ssm_c_im, 'ssm_d': ssm_d, 'ssm_glu_w': ssm_glu_w,
            'ssm_glu_b': ssm_glu_b, 'attn_q_norm': attn_q_norm,
            'attn_k_norm': attn_k_norm, 'attn_sink': attn_sink, 'ret_gn_w': ret_gn_w}


def reference(x, c, positions, norm_w, ada_w, ada_b, w_in, w_out,
              ssm_lam_re, ssm_lam_im, ssm_log_dt, ssm_b_re, ssm_b_im,
              ssm_c_re, ssm_c_im, ssm_d, ssm_glu_w, ssm_glu_b,
              attn_q_norm, attn_k_norm, attn_sink, ret_gn_w):
    Bn, L, _ = x.shape
    G, P = SSM_GROUPS, SSM_GROUP
    c_act = jax.nn.silu(c)
    for l in range(DEPTH):
        ada = c_act @ ada_w[l] + ada_b[l]
        shift, scale, gate = jnp.split(ada, 3, axis=-1)
        h = rms_norm(x, norm_w[l]) * (1.0 + scale[:, None, :]) + shift[:, None, :]
        z = h @ w_in[l]
        (s_u, s_gate, a_q, a_k, a_v, a_gate,
         r_q, r_k, r_v, r_gate) = jnp.split(z, _IN_SPLITS, axis=-1)

        u = s_u.reshape(Bn, L, G, P)
        y_s = (s5_direction(u, ssm_lam_re[l, 0], ssm_lam_im[l, 0], ssm_log_dt[l, 0],
                            ssm_b_re[l, 0], ssm_b_im[l, 0], ssm_c_re[l, 0], ssm_c_im[l, 0], False)
               + s5_direction(u, ssm_lam_re[l, 1], ssm_lam_im[l, 1], ssm_log_dt[l, 1],
                              ssm_b_re[l, 1], ssm_b_im[l, 1], ssm_c_re[l, 1], ssm_c_im[l, 1], True)
               + u * ssm_d[l].reshape(G, P))
        y_s = jax.nn.gelu(y_s.reshape(Bn, L, SSM_WIDTH)).astype(x.dtype)
        y_s = y_s * jax.nn.sigmoid(y_s @ ssm_glu_w[l] + ssm_glu_b[l])
        y_s = y_s * jax.nn.silu(s_gate)

        q = rms_norm(a_q.reshape(Bn, L, ATTN_HEADS, HEAD_DIM), attn_q_norm[l])
        k = rms_norm(a_k.reshape(Bn, L, ATTN_KV_HEADS, HEAD_DIM), attn_k_norm[l])
        q = rotary(q, positions, ROPE_DIMS, ROPE_THETA)
        k = rotary(k, positions, ROPE_DIMS, ROPE_THETA)
        vv = a_v.reshape(Bn, L, ATTN_KV_HEADS, HEAD_DIM)
        y_a = window_attention(q, k, vv, attn_sink[l]).reshape(Bn, L, ATTN_WIDTH)
        y_a = y_a * jax.nn.silu(a_gate)

        rq = rotary(r_q.reshape(Bn, L, RET_HEADS, HEAD_DIM), positions, HEAD_DIM, RET_THETA)
        rk = rotary(r_k.reshape(Bn, L, RET_HEADS, HEAD_DIM), positions, HEAD_DIM, RET_THETA)
        rv = r_v.reshape(Bn, L, RET_HEADS, HEAD_DIM)
        y_r = head_group_norm(bidirectional_retention(rq, rk, rv), ret_gn_w[l]).astype(x.dtype)
        y_r = y_r * jax.nn.silu(r_gate)

        y = jnp.concatenate([y_s.astype(x.dtype), y_a.astype(x.dtype), y_r.astype(x.dtype)], axis=-1) @ w_out[l]
        x = x + gate[:, None, :] * y
    return x
```

```cpp
#include <hip/hip_runtime.h>
#include <hip/hip_cooperative_groups.h>
#include <cstdio>
#include <cstdint>
namespace cg = cooperative_groups;

#define LAS __attribute__((address_space(3)))
typedef unsigned short bf16_t;
typedef short bf16x8 __attribute__((ext_vector_type(8)));
typedef float f32x4 __attribute__((ext_vector_type(4)));
typedef float f32x2 __attribute__((ext_vector_type(2)));
typedef float f32x16 __attribute__((ext_vector_type(16)));
typedef unsigned u32x4 __attribute__((ext_vector_type(4)));
typedef unsigned u32x2 __attribute__((ext_vector_type(2)));

constexpr int kT = 32768, kD = 2048, kL = 2048, kB = 16, kINW = 5632;
constexpr int kLdsBytes = 144 * 1024;

constexpr int ZC_U = 0, ZC_SG = 512, ZC_AQ = 1024, ZC_AK = 2048, ZC_AV = 2304, ZC_AG = 2560, ZC_RQ = 3584, ZC_RK = 4096, ZC_RV = 4608, ZC_RG = 5120;

__device__ __forceinline__ unsigned f2bf(float f) { unsigned u = __builtin_bit_cast(unsigned, f); return (u + 0x7fffu + ((u >> 16) & 1u)) >> 16; }
__device__ __forceinline__ unsigned pk2(float lo, float hi) { unsigned r; asm("v_cvt_pk_bf16_f32 %0, %1, %2" : "=v"(r) : "v"(lo), "v"(hi)); return r; }
__device__ __forceinline__ float bflo(unsigned w) { return __builtin_bit_cast(float, w << 16); }
__device__ __forceinline__ float bfhi(unsigned w) { return __builtin_bit_cast(float, w & 0xffff0000u); }
__device__ __forceinline__ float bf2f(bf16_t h) { return __builtin_bit_cast(float, ((unsigned)h) << 16); }
__device__ __forceinline__ float silu_f(float v) { return v * __builtin_amdgcn_rcpf(1.0f + __expf(-v)); }
__device__ __forceinline__ float sigmoid_f(float v) { return __builtin_amdgcn_rcpf(1.0f + __expf(-v)); }
__device__ __forceinline__ float gelu_tanh_f(float v) {
  const float u = 0.7978845608028654f * (v + 0.044715f * v * v * v);
  const float e = __expf(2.0f * u);
  const float th = 1.0f - 2.0f * __builtin_amdgcn_rcpf(e + 1.0f);
  return 0.5f * v * (1.0f + th);
}
__device__ __forceinline__ float wave_sum(float v) {
#pragma unroll
  for (int o = 32; o >= 1; o >>= 1) v += __shfl_xor(v, o);
  return v;
}
__device__ __forceinline__ float wave_max(float v) {
#pragma unroll
  for (int o = 32; o >= 1; o >>= 1) v = fmaxf(v, __shfl_xor(v, o));
  return v;
}
__device__ __forceinline__ f32x16 mfma32(bf16x8 a, bf16x8 b, f32x16 c) { return __builtin_amdgcn_mfma_f32_32x32x16_bf16(a, b, c, 0, 0, 0); }
__device__ __forceinline__ f32x16 zero16() { f32x16 z;
#pragma unroll
  for (int i = 0; i < 16; ++i) z[i] = 0.f; return z; }
__device__ __forceinline__ bf16x8 ldg8(const bf16_t* p) { return *(const bf16x8*)p; }
__device__ __forceinline__ bf16x8 lds8(const LAS unsigned char* p) { return *(const LAS bf16x8*)p; }

__device__ __forceinline__ int opaque_tid() { int t = threadIdx.x; asm volatile("" : "+v"(t)); return t; }
typedef unsigned short u16x4 __attribute__((ext_vector_type(4)));
#define TR_READ8(R, BASE, O0, O1, O2, O3, O4, O5, O6, O7) \
  asm volatile("ds_read_b64_tr_b16 %0, %8 offset:" #O0 "\n\tds_read_b64_tr_b16 %1, %8 offset:" #O1 "\n\tds_read_b64_tr_b16 %2, %8 offset:" #O2 "\n\tds_read_b64_tr_b16 %3, %8 offset:" #O3 \
               "\n\tds_read_b64_tr_b16 %4, %8 offset:" #O4 "\n\tds_read_b64_tr_b16 %5, %8 offset:" #O5 "\n\tds_read_b64_tr_b16 %6, %8 offset:" #O6 "\n\tds_read_b64_tr_b16 %7, %8 offset:" #O7 \
               "\n\ts_waitcnt lgkmcnt(0)" \
               : "=&v"(R[0]), "=&v"(R[1]), "=&v"(R[2]), "=&v"(R[3]), "=&v"(R[4]), "=&v"(R[5]), "=&v"(R[6]), "=&v"(R[7]) : "v"(BASE) : "memory")
__device__ __forceinline__ bf16x8 tr_join(u16x4 lo, u16x4 hi) { bf16x8 r; r[0] = (short)lo[0]; r[1] = (short)lo[1]; r[2] = (short)lo[2]; r[3] = (short)lo[3]; r[4] = (short)hi[0]; r[5] = (short)hi[1]; r[6] = (short)hi[2]; r[7] = (short)hi[3]; return r; }
#define TR_READ16(R, BASE, O0, O1, O2, O3, O4, O5, O6, O7, O8, O9, O10, O11, O12, O13, O14, O15) \
  asm volatile("ds_read_b64_tr_b16 %0, %16 offset:" #O0 "\n\tds_read_b64_tr_b16 %1, %16 offset:" #O1 "\n\tds_read_b64_tr_b16 %2, %16 offset:" #O2 "\n\tds_read_b64_tr_b16 %3, %16 offset:" #O3 \
               "\n\tds_read_b64_tr_b16 %4, %16 offset:" #O4 "\n\tds_read_b64_tr_b16 %5, %16 offset:" #O5 "\n\tds_read_b64_tr_b16 %6, %16 offset:" #O6 "\n\tds_read_b64_tr_b16 %7, %16 offset:" #O7 \
               "\n\tds_read_b64_tr_b16 %8, %16 offset:" #O8 "\n\tds_read_b64_tr_b16 %9, %16 offset:" #O9 "\n\tds_read_b64_tr_b16 %10, %16 offset:" #O10 "\n\tds_read_b64_tr_b16 %11, %16 offset:" #O11 \
               "\n\tds_read_b64_tr_b16 %12, %16 offset:" #O12 "\n\tds_read_b64_tr_b16 %13, %16 offset:" #O13 "\n\tds_read_b64_tr_b16 %14, %16 offset:" #O14 "\n\tds_read_b64_tr_b16 %15, %16 offset:" #O15 \
               "\n\ts_waitcnt lgkmcnt(0)" \
               : "=&v"(R[0]), "=&v"(R[1]), "=&v"(R[2]), "=&v"(R[3]), "=&v"(R[4]), "=&v"(R[5]), "=&v"(R[6]), "=&v"(R[7]), "=&v"(R[8]), "=&v"(R[9]), "=&v"(R[10]), "=&v"(R[11]), "=&v"(R[12]), "=&v"(R[13]), "=&v"(R[14]), "=&v"(R[15]) : "v"(BASE) : "memory")

#define XB_TMO      128
#define XB_XCNT(j)  (256  + 64 * (j))
#define XB_XSUB(j)  (1280 + 64 * (j))
#define XB_XGEN(j)  (2304 + 64 * (j))
#define XB_TOP      3328
#define XB_TOPGEN   3392
#define XCD_BAR_WORDS 3456
#define XB_SPIN_CAP (1u << 18)

__device__ __forceinline__ unsigned xb_ld(unsigned* p)              { return __hip_atomic_load(p, __ATOMIC_RELAXED, __HIP_MEMORY_SCOPE_AGENT); }
__device__ __forceinline__ unsigned xb_add(unsigned* p, unsigned v) { return __hip_atomic_fetch_add(p, v, __ATOMIC_RELAXED, __HIP_MEMORY_SCOPE_AGENT); }
__device__ __forceinline__ unsigned xb_xcc_id() { return (unsigned)__builtin_amdgcn_s_getreg((3 << 11) | 20) & 0xFu; }

#define XB_SPIN(cond, bar) do { unsigned _sp = 0; while (cond) { __builtin_amdgcn_s_sleep(1); \
    if ((++_sp & 255u) == 0u) { if (xb_ld(&(bar)[XB_TMO])) break; if (_sp > XB_SPIN_CAP) { atomicAdd(&(bar)[XB_TMO], 1u); break; } } } } while (0)

struct XcdBarrier {
    unsigned* bar; unsigned x;
    volatile LAS unsigned* st;
};


__device__ __forceinline__ XcdBarrier xcd_barrier_post(unsigned* bar, volatile LAS unsigned* st) {
    XcdBarrier b; b.bar = bar; b.x = xb_xcc_id(); b.st = st;
    if (threadIdx.x == 0) (void)xb_add(&bar[XB_XCNT(b.x)], 1u);
    return b;
}


__device__ __forceinline__ void xcd_barrier_complete(unsigned* bar, unsigned x, unsigned& nloc, unsigned& nx) {
    const unsigned G = gridDim.x * gridDim.y * gridDim.z;
    unsigned sum, cnt, mine, sp = 0u;
    for (;;) {
        sum = 0u; cnt = 0u; mine = 0u;
#pragma unroll
        for (unsigned j = 0; j < 16; ++j) { const unsigned c = xb_ld(&bar[XB_XCNT(j)]); sum += c; cnt += (c > 0u) ? 1u : 0u; mine = (j == x) ? c : mine; }
        if (sum == G) break;
        __builtin_amdgcn_s_sleep(1);
        if ((++sp & 255u) == 0u) { if (xb_ld(&bar[XB_TMO])) break; if (sp > XB_SPIN_CAP) { atomicAdd(&bar[XB_TMO], 1u); break; } }
    }
    nloc = mine > 0u ? mine : 1u; nx = cnt > 0u ? cnt : 1u;
}


__device__ __forceinline__ void xcd_barrier(const XcdBarrier& b) {
    asm volatile("s_waitcnt vmcnt(0)" ::: "memory");
    __syncthreads();
    if (threadIdx.x == 0) {
        unsigned* bar = b.bar;
        __builtin_amdgcn_s_waitcnt(0);
        unsigned nloc = b.st[0], nx = b.st[1];
        if (nloc == 0u) { xcd_barrier_complete(bar, b.x, nloc, nx); b.st[0] = nloc; b.st[1] = nx; }
        const unsigned old = xb_add(&bar[XB_XSUB(b.x)], 1u);
        const unsigned gen = old / nloc;
        if (old + 1u == (gen + 1u) * nloc) {
            __builtin_amdgcn_fence(__ATOMIC_RELEASE, "agent");
            asm volatile("s_waitcnt vmcnt(0)" ::: "memory");


            const unsigned og = xb_add(&bar[XB_TOP], 1u);
            const unsigned tg = og / nx;
            if (og + 1u == (tg + 1u) * nx) xb_add(&bar[XB_TOPGEN], 1u);
            else XB_SPIN(xb_ld(&bar[XB_TOPGEN]) == tg, bar);
            __builtin_amdgcn_fence(__ATOMIC_ACQUIRE, "agent");
            xb_add(&bar[XB_XGEN(b.x)], 1u);
            asm volatile("s_waitcnt vmcnt(0)" ::: "memory");

        } else {
            XB_SPIN(xb_ld(&bar[XB_XGEN(b.x)]) == gen, bar);
            __builtin_amdgcn_fence(__ATOMIC_ACQUIRE, "agent");


            asm volatile("s_waitcnt vmcnt(0)" ::: "memory");
        }
    }
    __syncthreads();
}
namespace pg8 {
#define PG8_LAS __attribute__((address_space(3)))
typedef unsigned short bf16_t;
typedef short bf16x8 __attribute__((ext_vector_type(8)));
typedef float f32x4 __attribute__((ext_vector_type(4)));
typedef unsigned u32x4 __attribute__((ext_vector_type(4)));
constexpr int BM = 256, BK = 64, HALF = 128, HTB = HALF * BK * 2  , STAGE_BYTES = 8 * HTB, NXCD = 8, WGM = 8;


__host__ __device__ __forceinline__ int lds_byte(int r, int c) { const int st = (r >> 4) * 2 + (c >> 5), rr = r & 15, cc = c & 31, ob = rr * 64 + cc * 2; return st * 1024 + (ob ^ (((ob >> 9) & 1) << 5)); }
__host__ __device__ __forceinline__ void stage_rc(int b, int& R, int& C) { const int st = b / 1024, sb = b % 1024, swz = sb ^ (((sb >> 9) & 1) << 5); R = (st >> 1) * 16 + swz / 64; C = (st & 1) * 32 + (swz % 64) / 2; }
__host__ __device__ __forceinline__ int perm32(int rho) { const int n = rho >> 4, i = rho & 15; return 8 * (i >> 2) + 4 * n + (i & 3); }
struct Unit { int pm, pn; };
struct Gemm { const bf16_t* A; const bf16_t* Bt; int M, N, K; };
struct StaticOrder {
    int nM, nN, nwg, G, c;
    __host__ __device__ void init(int M, int N, int G_, int c_) { nM = M / BM; nN = N / BM; nwg = nM * nN; G = G_; c = c_; }
    __host__ __device__ bool next(int i, Unit& u) const {
        const long L = (long)i * G + c; if (L >= nwg) return false;
        int wgid = (int)L; { const int q = nwg / NXCD, r = nwg % NXCD, xcd = wgid % NXCD, off = wgid / NXCD; wgid = (xcd < r ? xcd * (q + 1) : r * (q + 1) + (xcd - r) * q) + off; }
        const int nig = WGM * nN, gid = wgid / nig, fm = gid * WGM, gsz = (nM - fm) < WGM ? (nM - fm) : WGM;
        u.pm = fm + ((wgid % nig) % gsz); u.pn = (wgid % nig) / gsz; return true;
    }
    __device__ __forceinline__ void a_ready(const Unit&) const {}
    __device__ __forceinline__ void done(const Unit&) const {}
};
__device__ __forceinline__ unsigned cvt_pk_bf16(float lo, float hi) { unsigned r; asm volatile("v_cvt_pk_bf16_f32 %0, %1, %2" : "=v"(r) : "v"(lo), "v"(hi)); return r; }
template <class Epi, class Sched, bool ALIGN_EPI = false, bool SP2 = false>
__device__ __forceinline__ void gemm_phase(PG8_LAS unsigned char* lds, const Gemm g, const Sched& S, const Epi& E) {
    const int tid = opaque_tid(), wid = __builtin_amdgcn_readfirstlane(tid >> 6), lane = tid & 63, wr = wid >> 2, wc = wid & 3, fr = lane & 15, fq = lane >> 4;
    const int K = g.K, nt = K / BK;

    unsigned voffA[2], voffB[2];
#pragma unroll
    for (int i = 0; i < 2; ++i) { int R, C; stage_rc(tid * 16 + i * 8192, R, C); const int Rb = Epi::PERM ? ((R & ~31) + perm32(R & 31)) : R;
        voffA[i] = (unsigned)(R * K + C) * 2u; voffB[i] = (unsigned)(Rb * K + C) * 2u; }
    const size_t kstep = (size_t)(BK * 2);
    const size_t hstep = (size_t)HALF * K * 2;
    const size_t tstep = 2 * hstep;
    const unsigned ldsw = (unsigned)wid * 1024u;

    const int aoff = lds_byte(wr * 64 + fr, fq * 8), boff = lds_byte(wc * 32 + fr, fq * 8);
#define PG8_SA(b, h) (((b) * 2 + (h)) * HTB)
#define PG8_SB(b, h) ((4 + (b) * 2 + (h)) * HTB)
#define PG8_STAGE(bufoff, gbase, voff) do { _Pragma("unroll") for (int _i = 0; _i < 2; ++_i) \
        __builtin_amdgcn_global_load_lds((const unsigned*)((const char*)(gbase) + (voff)[_i]), (PG8_LAS unsigned*)(lds + (bufoff) + ldsw + _i * 8192), 16, 0, 0); } while (0)
#define PG8_LDA(dst, b, h) do { _Pragma("unroll") for (int m = 0; m < 4; ++m) _Pragma("unroll") for (int k = 0; k < 2; ++k) dst[m][k] = *(const PG8_LAS bf16x8*)(lds + PG8_SA(b, h) + aoff + m * 2048 + k * 1024); } while (0)
#define PG8_LDB(dst, b, h) do { _Pragma("unroll") for (int n = 0; n < 2; ++n) _Pragma("unroll") for (int k = 0; k < 2; ++k) dst[n][k] = *(const PG8_LAS bf16x8*)(lds + PG8_SB(b, h) + boff + n * 2048 + k * 1024); } while (0)
#define PG8_MMA(ai, bj, At, Bt) do { __builtin_amdgcn_s_setprio(1); _Pragma("unroll") for (int m = 0; m < 4; ++m) _Pragma("unroll") for (int n = 0; n < 2; ++n) _Pragma("unroll") for (int k = 0; k < 2; ++k) \
        acc[ai][bj][m][n] = __builtin_amdgcn_mfma_f32_16x16x32_bf16(Bt[n][k], At[m][k], acc[ai][bj][m][n], 0, 0, 0); __builtin_amdgcn_s_setprio(0); } while (0)
#define PG8_WAIT_V(n) asm volatile("s_waitcnt vmcnt(" #n ")" ::: "memory")
#define PG8_WAIT_L(n) asm volatile("s_waitcnt lgkmcnt(" #n ")" ::: "memory")
#define PG8_BAR __builtin_amdgcn_s_barrier()
#define PG8_SCHED __builtin_amdgcn_sched_barrier(0)
    Unit cur, nxt; int ui = 0;
    if (!S.next(0, cur)) return;
    f32x4 acc[2][2][4][2];
#pragma unroll
    for (int a = 0; a < 2; ++a)
#pragma unroll
        for (int b = 0; b < 2; ++b)
#pragma unroll
            for (int m = 0; m < 4; ++m)
#pragma unroll
                for (int n = 0; n < 2; ++n) acc[a][b][m][n] = (f32x4){0.f, 0.f, 0.f, 0.f};
    bf16x8 At[4][2], B0[2][2], B1[2][2];

    const char* cA = (const char*)g.A + (size_t)cur.pm * tstep; const char* cB = (const char*)g.Bt + (size_t)cur.pn * tstep;
    S.a_ready(cur);

    if constexpr (SP2) {
        PG8_STAGE(PG8_SB(0, 0), cB, voffB); PG8_STAGE(PG8_SB(0, 1), cB + hstep, voffB); PG8_STAGE(PG8_SA(0, 0), cA, voffA); PG8_STAGE(PG8_SA(0, 1), cA + hstep, voffA);
        if (wr == 1) PG8_BAR;
        PG8_WAIT_V(2); PG8_BAR;
        PG8_STAGE(PG8_SB(1, 0), cB + kstep, voffB); PG8_STAGE(PG8_SA(1, 0), cA + kstep, voffA); PG8_STAGE(PG8_SB(1, 1), cB + hstep + kstep, voffB);
        PG8_WAIT_V(6); PG8_BAR;
    } else {
        PG8_STAGE(PG8_SB(0, 0), cB, voffB); PG8_STAGE(PG8_SA(0, 0), cA, voffA); PG8_STAGE(PG8_SB(0, 1), cB + hstep, voffB); PG8_STAGE(PG8_SA(0, 1), cA + hstep, voffA);
        if (wr == 1) PG8_BAR;
        PG8_WAIT_V(4); PG8_BAR;
        PG8_STAGE(PG8_SB(1, 0), cB + kstep, voffB); PG8_STAGE(PG8_SA(1, 0), cA + kstep, voffA); PG8_STAGE(PG8_SB(1, 1), cB + hstep + kstep, voffB);
        PG8_WAIT_V(6); PG8_BAR;
    }
    for (;;) {
        const bool has_next = S.next(ui + 1, nxt);

        const char* nA = has_next ? (const char*)g.A + (size_t)nxt.pm * tstep : cA; const char* nB = has_next ? (const char*)g.Bt + (size_t)nxt.pn * tstep : cB;
        for (int t = 0; t < nt; t += 2) {
            const bool last = (t == nt - 2);
            const char* a1 = cA + (size_t)(t + 1) * kstep;
            const char* a2 = last ? nA : cA + (size_t)(t + 2) * kstep; const char* b2 = last ? nB : cB + (size_t)(t + 2) * kstep;
            const char* a3 = a2 + kstep; const char* b3 = b2 + kstep;
            if (last && has_next) S.a_ready(nxt);
            if constexpr (SP2) {


            PG8_LDB(B0, 0, 0); PG8_LDB(B1, 0, 1); PG8_SCHED; PG8_LDA(At, 0, 0); PG8_STAGE(PG8_SA(1, 1), a1 + hstep, voffA);
            PG8_WAIT_V(8); PG8_WAIT_L(0); PG8_BAR; PG8_MMA(0, 0, At, B0); PG8_MMA(0, 1, At, B1); PG8_BAR; PG8_SCHED;

            PG8_LDA(At, 0, 1); PG8_STAGE(PG8_SB(0, 0), b2, voffB); PG8_STAGE(PG8_SB(0, 1), b2 + hstep, voffB); PG8_STAGE(PG8_SA(0, 0), a2, voffA);
            PG8_WAIT_V(8); PG8_WAIT_L(0); PG8_BAR; PG8_MMA(1, 0, At, B0); PG8_MMA(1, 1, At, B1); PG8_BAR; PG8_SCHED;

            PG8_LDB(B0, 1, 0); PG8_LDB(B1, 1, 1); PG8_SCHED; PG8_LDA(At, 1, 0); PG8_STAGE(PG8_SA(0, 1), a2 + hstep, voffA);
            PG8_WAIT_V(8); PG8_WAIT_L(0); PG8_BAR; PG8_MMA(0, 0, At, B0); PG8_MMA(0, 1, At, B1); PG8_BAR; PG8_SCHED;

            PG8_LDA(At, 1, 1); PG8_STAGE(PG8_SB(1, 0), b3, voffB); PG8_STAGE(PG8_SB(1, 1), b3 + hstep, voffB); PG8_STAGE(PG8_SA(1, 0), a3, voffA);
            PG8_WAIT_V(8); PG8_WAIT_L(0); PG8_BAR; PG8_MMA(1, 0, At, B0); PG8_MMA(1, 1, At, B1); PG8_BAR; PG8_SCHED;
            } else {

            PG8_LDB(B0, 0, 0); PG8_SCHED; PG8_LDA(At, 0, 0); PG8_STAGE(PG8_SA(1, 1), a1 + hstep, voffA);
            PG8_WAIT_L(8); PG8_BAR; PG8_WAIT_L(0); PG8_MMA(0, 0, At, B0); PG8_BAR; PG8_SCHED;

            PG8_LDB(B1, 0, 1); PG8_STAGE(PG8_SB(0, 0), b2, voffB);
            PG8_BAR; PG8_WAIT_L(0); PG8_MMA(0, 1, At, B1); PG8_BAR;

            PG8_LDA(At, 0, 1); PG8_STAGE(PG8_SA(0, 0), a2, voffA);
            PG8_BAR; PG8_WAIT_L(0); PG8_MMA(1, 0, At, B0); PG8_BAR; PG8_SCHED;

            PG8_STAGE(PG8_SB(0, 1), b2 + hstep, voffB);
            PG8_WAIT_V(6); PG8_BAR; PG8_MMA(1, 1, At, B1); PG8_BAR;

            PG8_LDB(B0, 1, 0); PG8_SCHED; PG8_LDA(At, 1, 0); PG8_STAGE(PG8_SA(0, 1), a2 + hstep, voffA);
            PG8_WAIT_L(8); PG8_BAR; PG8_WAIT_L(0); PG8_MMA(0, 0, At, B0); PG8_BAR; PG8_SCHED;

            PG8_LDB(B1, 1, 1); PG8_STAGE(PG8_SB(1, 0), b3, voffB);
            PG8_BAR; PG8_WAIT_L(0); PG8_MMA(0, 1, At, B1); PG8_BAR;

            PG8_LDA(At, 1, 1); PG8_STAGE(PG8_SA(1, 0), a3, voffA);
            PG8_BAR; PG8_WAIT_L(0); PG8_MMA(1, 0, At, B0); PG8_BAR; PG8_SCHED;

            PG8_STAGE(PG8_SB(1, 1), b3 + hstep, voffB);
            PG8_WAIT_V(6); PG8_BAR; PG8_MMA(1, 1, At, B1); PG8_BAR;
            }
        }
        if constexpr (ALIGN_EPI) { if (wr == 0) PG8_BAR; }
        if constexpr (!Epi::AFTER_DRAIN) { E(acc, cur, wr, wc, fr, fq); S.done(cur); }
        if (!has_next) break;
#pragma unroll
        for (int a = 0; a < 2; ++a)
#pragma unroll
            for (int b = 0; b < 2; ++b)
#pragma unroll
                for (int m = 0; m < 4; ++m)
#pragma unroll
                    for (int n = 0; n < 2; ++n) acc[a][b][m][n] = (f32x4){0.f, 0.f, 0.f, 0.f};
        cur = nxt; cA = nA; cB = nB; ++ui;
        if constexpr (ALIGN_EPI) { if (wr == 1) PG8_BAR; }
    }
    PG8_WAIT_V(0);
    if constexpr (!ALIGN_EPI) { if (wr == 0) PG8_BAR; }
    PG8_BAR;
    if constexpr (Epi::AFTER_DRAIN) { E.fused(acc, cur, wr, wc, fr, fq, lds, wid, lane); S.done(cur); }
#undef PG8_SA
#undef PG8_SB
#undef PG8_STAGE
#undef PG8_LDA
#undef PG8_LDB
#undef PG8_MMA
#undef PG8_WAIT_V
#undef PG8_WAIT_L
#undef PG8_BAR
#undef PG8_SCHED
}
}

constexpr size_t WS_WIN = 0;
constexpr size_t WS_WOUT = WS_WIN + (size_t)2 * 5632 * 2048 * 2;
constexpr size_t WS_GLU = WS_WOUT + (size_t)2 * 2048 * 2048 * 2;
constexpr size_t WS_ADA = WS_GLU + (size_t)2 * 512 * 512 * 2;
constexpr size_t WS_EE = WS_ADA + (size_t)2 * 16 * 6144 * 4;
constexpr size_t WS_MF = WS_EE + (size_t)2 * 32 * 256 * 256 * 2;
constexpr size_t WS_A16 = WS_MF + (size_t)2 * 32 * 256 * 512 * 2;
constexpr size_t WS_H = WS_A16 + (size_t)2 * 32 * 2 * 64 * 2 * 4;
constexpr size_t WS_Z = WS_H + (size_t)kT * 2048 * 2;
constexpr size_t WS_AVT = WS_Z + (size_t)kT * kINW * 2;
constexpr size_t WS_RKF = WS_AVT + (size_t)16 * 2 * 128 * 2048 * 2;
constexpr size_t WS_RKB = WS_RKF + (size_t)16 * 4 * 128 * 2048 * 2;
constexpr size_t WS_RVT = WS_RKB + (size_t)16 * 4 * 128 * 2048 * 2;
constexpr size_t WS_UB = WS_RVT + (size_t)16 * 4 * 128 * 2048 * 2;
constexpr size_t WS_YS = WS_UB + (size_t)kT * 512 * 2;
constexpr size_t WS_KVF = WS_YS + (size_t)kT * 512 * 2;
constexpr size_t WS_KVB = WS_KVF + (size_t)16 * 4 * 16 * 16384 * 4;
constexpr size_t WS_SP = WS_KVB + (size_t)16 * 4 * 16 * 16384 * 4;
constexpr size_t WS_SF = WS_SP + (size_t)16 * 4 * 16 * 16384 * 2;
constexpr size_t WS_RA = WS_SF + (size_t)16 * 4 * 16 * 16384 * 2;
constexpr size_t WS_RR = WS_RA + (size_t)kT * 16 * 8;
constexpr size_t WS_CTL = WS_RR + (size_t)kT * 64 * 8;
constexpr size_t CTL_BYTES = 16384;
constexpr size_t WS_END = WS_CTL + CTL_BYTES;
static_assert(WS_END <= (size_t)1073741824, "workspace fits 1 GiB");

struct Params { const float* in[22]; float* out; unsigned char* ws; };

struct EpiZ {
  static constexpr bool PERM = true, AFTER_DRAIN = false;
  bf16_t* Z;
  __device__ __forceinline__ void operator()(const f32x4 (&acc)[2][2][4][2], const pg8::Unit& u, int wr, int wc, int fr, int fq) const {
    const int pn = u.pn;
    const bool gate = (pn == 2 || pn == 3 || (pn >= 10 && pn <= 13) || pn >= 20);
    const int row0 = u.pm * 256 + wr * 64 + fr, col0 = pn * 256 + wc * 32 + 8 * fq;
#pragma unroll
    for (int ai = 0; ai < 2; ++ai)
#pragma unroll
      for (int m = 0; m < 4; ++m) {
        bf16_t* rowp = Z + (size_t)(row0 + ai * 128 + m * 16) * kINW + col0;
#pragma unroll
        for (int bj = 0; bj < 2; ++bj) {
          f32x4 v0 = acc[ai][bj][m][0], v1 = acc[ai][bj][m][1];
          if (gate) {
#pragma unroll
            for (int j = 0; j < 4; ++j) { v0[j] = silu_f(v0[j]); v1[j] = silu_f(v1[j]); }
          }
          u32x4 w; w.x = pk2(v0[0], v0[1]); w.y = pk2(v0[2], v0[3]); w.z = pk2(v1[0], v1[1]); w.w = pk2(v1[2], v1[3]);
          *(u32x4*)(rowp + bj * 128) = w;
        }
      }
  }
};
struct EpiGlu {
  static constexpr bool PERM = true, AFTER_DRAIN = false;
  const bf16_t* YS; const bf16_t* Z; const float* bias; bf16_t* YC;
  __device__ __forceinline__ void operator()(const f32x4 (&acc)[2][2][4][2], const pg8::Unit& u, int wr, int wc, int fr, int fq) const {
    const int row0 = u.pm * 256 + wr * 64 + fr, col0 = u.pn * 256 + wc * 32 + 8 * fq;
    f32x4 bv[2][2];
#pragma unroll
    for (int bj = 0; bj < 2; ++bj) { bv[bj][0] = *(const f32x4*)(bias + col0 + bj * 128); bv[bj][1] = *(const f32x4*)(bias + col0 + bj * 128 + 4); }
#pragma unroll
    for (int ai = 0; ai < 2; ++ai)
#pragma unroll
      for (int mp = 0; mp < 2; ++mp) {
        u32x4 yv[2][2], gv[2][2];
#pragma unroll
        for (int mm = 0; mm < 2; ++mm)
#pragma unroll
          for (int bj = 0; bj < 2; ++bj) {
            const size_t row = (size_t)(row0 + ai * 128 + (mp * 2 + mm) * 16); const int col = col0 + bj * 128;
            yv[mm][bj] = *(const u32x4*)(YS + row * 512 + col); gv[mm][bj] = *(const u32x4*)(Z + row * kINW + ZC_SG + col);
          }
#pragma unroll
        for (int mm = 0; mm < 2; ++mm)
#pragma unroll
          for (int bj = 0; bj < 2; ++bj) {
            const int m = mp * 2 + mm;
            const size_t row = (size_t)(row0 + ai * 128 + m * 16); const int col = col0 + bj * 128;
            const f32x4 a0 = acc[ai][bj][m][0] + bv[bj][0], a1 = acc[ai][bj][m][1] + bv[bj][1];
            const u32x4 y4 = yv[mm][bj], g4 = gv[mm][bj];
            u32x4 w;
            w.x = pk2(bflo(y4.x) * sigmoid_f(a0[0]) * bflo(g4.x), bfhi(y4.x) * sigmoid_f(a0[1]) * bfhi(g4.x));
            w.y = pk2(bflo(y4.y) * sigmoid_f(a0[2]) * bflo(g4.y), bfhi(y4.y) * sigmoid_f(a0[3]) * bfhi(g4.y));
            w.z = pk2(bflo(y4.z) * sigmoid_f(a1[0]) * bflo(g4.z), bfhi(y4.z) * sigmoid_f(a1[1]) * bfhi(g4.z));
            w.w = pk2(bflo(y4.w) * sigmoid_f(a1[2]) * bflo(g4.w), bfhi(y4.w) * sigmoid_f(a1[3]) * bfhi(g4.w));
            *(u32x4*)(YC + row * 2048 + col) = w;
          }
      }
  }
};
struct EpiOut {
  static constexpr bool PERM = false, AFTER_DRAIN = false;
  const float* Xin; float* Xout; const float* gate;
  __device__ __forceinline__ void operator()(const f32x4 (&acc)[2][2][4][2], const pg8::Unit& u, int wr, int wc, int fr, int fq) const {
    const int row0 = u.pm * 256 + wr * 64 + fr, col0 = u.pn * 256 + wc * 32 + 4 * fq;
    const float* gp = gate + (size_t)(u.pm >> 3) * 6144 + col0;
    f32x4 gv[2][2];
#pragma unroll
    for (int bj = 0; bj < 2; ++bj)
#pragma unroll
      for (int n = 0; n < 2; ++n) gv[bj][n] = *(const f32x4*)(gp + bj * 128 + n * 16);
#pragma unroll
    for (int ai = 0; ai < 2; ++ai)
#pragma unroll
      for (int mp = 0; mp < 2; ++mp) {
        f32x4 xv[2][2][2];
#pragma unroll
        for (int mm = 0; mm < 2; ++mm)
#pragma unroll
          for (int bj = 0; bj < 2; ++bj)
#pragma unroll
            for (int n = 0; n < 2; ++n) xv[mm][bj][n] = *(const f32x4*)(Xin + (size_t)(row0 + ai * 128 + (mp * 2 + mm) * 16) * 2048 + col0 + bj * 128 + n * 16);
#pragma unroll
        for (int mm = 0; mm < 2; ++mm)
#pragma unroll
          for (int bj = 0; bj < 2; ++bj)
#pragma unroll
            for (int n = 0; n < 2; ++n)
              *(f32x4*)(Xout + (size_t)(row0 + ai * 128 + (mp * 2 + mm) * 16) * 2048 + col0 + bj * 128 + n * 16) = xv[mm][bj][n] + gv[bj][n] * acc[ai][bj][mp * 2 + mm][n];
      }
  }
};

__device__ __forceinline__ float lgam2(int h) { return log1pf(-exp2f(-5.0f - (float)h)) * 1.4426950408889634f; }

struct TrUnit { const float* src; bf16_t* dst; int N, K; };
__device__ __forceinline__ TrUnit tr_decode(const Params& p, int u) {
  const int l = u / 3904, r = u % 3904; TrUnit t;
  if (r < 2816) { const int tk = r / 88, tn = r % 88; t.N = 5632; t.K = 2048; t.src = p.in[6] + (size_t)l * 2048 * 5632 + (size_t)tk * 64 * 5632 + tn * 64; t.dst = (bf16_t*)(p.ws + WS_WIN) + (size_t)l * 5632 * 2048 + (size_t)tn * 64 * 2048 + tk * 64; }
  else if (r < 3840) { const int q = r - 2816, tk = q >> 5, tn = q & 31; t.N = 2048; t.K = 2048; t.src = p.in[7] + (size_t)l * 2048 * 2048 + (size_t)tk * 64 * 2048 + tn * 64; t.dst = (bf16_t*)(p.ws + WS_WOUT) + (size_t)l * 2048 * 2048 + (size_t)tn * 64 * 2048 + tk * 64; }
  else { const int q = r - 3840, tk = q >> 3, tn = q & 7; t.N = 512; t.K = 512; t.src = p.in[16] + (size_t)l * 512 * 512 + (size_t)tk * 64 * 512 + tn * 64; t.dst = (bf16_t*)(p.ws + WS_GLU) + (size_t)l * 512 * 512 + (size_t)tn * 64 * 512 + tk * 64; }
  return t;
}
__device__ __forceinline__ void tr_load(const Params& p, int u, int tid, f32x4 (&v)[2]) {
  if (u < 7808) { const TrUnit t = tr_decode(p, u);
#pragma unroll
    for (int i = 0; i < 2; ++i) { const int idx = tid + i * 512, r = idx >> 4, c4 = idx & 15; v[i] = *(const f32x4*)(t.src + (size_t)r * t.N + c4 * 4); } }
}
__device__ __forceinline__ void tr_store(const Params& p, int u, int tid, const f32x4 (&v)[2], LAS float* scr) {
  if (u < 7808) {
    const TrUnit t = tr_decode(p, u);
    __syncthreads();
#pragma unroll
    for (int i = 0; i < 2; ++i) { const int idx = tid + i * 512, r = idx >> 4, c4 = idx & 15; LAS float* d = scr + r * 65 + c4 * 4; d[0] = v[i][0]; d[1] = v[i][1]; d[2] = v[i][2]; d[3] = v[i][3]; }
    __syncthreads();
    const int n = tid >> 3, kc = tid & 7;
    float f[8];
#pragma unroll
    for (int j = 0; j < 8; ++j) f[j] = scr[(kc * 8 + j) * 65 + n];
    u32x4 w; w.x = pk2(f[0], f[1]); w.y = pk2(f[2], f[3]); w.z = pk2(f[4], f[5]); w.w = pk2(f[6], f[7]);
    *(u32x4*)(t.dst + (size_t)n * t.K + kc * 8) = w;
  }
}

__device__ __forceinline__ void ada_unit(const Params& p, int u, LAS unsigned char* lds, int tid) {
  const int l = u / 96, cgp = u % 96, lane = tid & 63, wave = tid >> 6;
  const int kq = lane >> 4, c4 = lane & 15;
  LAS float* cact = (LAS float*)lds;
  const float* c = p.in[1];
  __syncthreads();
  for (int i = tid; i < 8192; i += 512) {
    const int k = i & 2047, bq = i >> 11;
    f32x4 v; v[0] = silu_f(c[(4 * bq) * 2048 + k]); v[1] = silu_f(c[(4 * bq + 1) * 2048 + k]); v[2] = silu_f(c[(4 * bq + 2) * 2048 + k]); v[3] = silu_f(c[(4 * bq + 3) * 2048 + k]);
    *(LAS f32x4*)(cact + k * 16 + 4 * bq) = v;
  }
  __syncthreads();
  const float* W = p.in[4] + (size_t)l * 2048 * 6144 + cgp * 64 + 4 * c4;
  f32x4 acc[16];
#pragma unroll
  for (int b = 0; b < 16; ++b) acc[b] = (f32x4){0.f, 0.f, 0.f, 0.f};
  for (int i0 = 0; i0 < 64; i0 += 16) {
    f32x4 wv[16];
#pragma unroll
    for (int ii = 0; ii < 16; ++ii) wv[ii] = *(const f32x4*)(W + (size_t)(wave * 256 + 4 * (i0 + ii) + kq) * 6144);
#pragma unroll
    for (int ii = 0; ii < 16; ++ii) {
      const int k = wave * 256 + 4 * (i0 + ii) + kq;
      const f32x4 c0 = *(LAS f32x4*)(cact + k * 16), c1 = *(LAS f32x4*)(cact + k * 16 + 4), c2 = *(LAS f32x4*)(cact + k * 16 + 8), c3 = *(LAS f32x4*)(cact + k * 16 + 12);
#pragma unroll
      for (int j = 0; j < 4; ++j) { acc[j] += wv[ii] * c0[j]; acc[4 + j] += wv[ii] * c1[j]; acc[8 + j] += wv[ii] * c2[j]; acc[12 + j] += wv[ii] * c3[j]; }
    }
  }
#pragma unroll
  for (int b = 0; b < 16; ++b)
#pragma unroll
    for (int j = 0; j < 4; ++j) { float v = acc[b][j]; v += __shfl_xor(v, 16); v += __shfl_xor(v, 32); acc[b][j] = v; }
  __syncthreads();
  LAS float* red = (LAS float*)lds;
  if (kq == 0) {
#pragma unroll
    for (int b = 0; b < 16; ++b) *(LAS f32x4*)(red + (wave * 16 + b) * 64 + 4 * c4) = acc[b];
  }
  __syncthreads();
  float* ada = (float*)(p.ws + WS_ADA);
#pragma unroll
  for (int i = 0; i < 2; ++i) {
    const int o = tid + i * 512, b = o >> 6, nn = o & 63;
    float s = 0.f;
#pragma unroll
    for (int w = 0; w < 8; ++w) s += red[(w * 16 + b) * 64 + nn];
    ada[(size_t)(l * 16 + b) * 6144 + cgp * 64 + nn] = s + p.in[5][l * 6144 + cgp * 64 + nn];
  }
  __syncthreads();
}

__device__ __forceinline__ void s5mat_unit(const Params& p, int u, LAS unsigned char* lds, int tid) {
  const int l = u >> 5, g = u & 31;
  LAS float* pwre = (LAS float*)lds;
  LAS float* pwim = pwre + 2176;
  LAS float* bbre = pwim + 2176;
  LAS float* bbim = bbre + 2048;
  LAS float* cre = bbim + 2048;
  LAS float* cim = cre + 2048;
  LAS float* Kf = cim + 2048;
  LAS float* Kb = Kf + 4096;
  __syncthreads();
  if (tid < 128) {
    const int dir = tid >> 6, n = tid & 63;
    const int ig = (l * 2 + dir) * 32 + g;
    const float dt = expf(p.in[10][ig]);
    const float lr = p.in[8][ig * 64 + n], li = p.in[9][ig * 64 + n];
    for (int k = 0; k <= 16; ++k) {
      const float mag = expf(lr * dt * (float)k); float s, c; sincosf(li * dt * (float)k, &s, &c);
      pwre[(dir * 17 + k) * 64 + n] = mag * c; pwim[(dir * 17 + k) * 64 + n] = mag * s;
    }
    const float mag = expf(lr * dt); float s1, c1; sincosf(li * dt, &s1, &c1);
    const float abr = mag * c1, abi = mag * s1, nr = abr - 1.0f, den = lr * lr + li * li;
    const float fre = (nr * lr + abi * li) / den, fim = (abi * lr - nr * li) / den;
    for (int q = 0; q < 16; ++q) {
      const float br = p.in[11][((size_t)ig * 64 + n) * 16 + q], bi = p.in[12][((size_t)ig * 64 + n) * 16 + q];
      bbre[(dir * 64 + n) * 16 + q] = fre * br - fim * bi; bbim[(dir * 64 + n) * 16 + q] = fre * bi + fim * br;
    }
    float* a16 = (float*)(p.ws + WS_A16) + ((size_t)((l * 32 + g) * 2 + dir) * 64 + n) * 2;
    const float m16 = expf(lr * dt * 16.0f); float s16, c16; sincosf(li * dt * 16.0f, &s16, &c16);
    a16[0] = m16 * c16; a16[1] = m16 * s16;
  }
  for (int i = tid; i < 2048; i += 512) {
    const int dir = i >> 10, r = i & 1023;
    const size_t gi = ((size_t)((l * 2 + dir) * 32 + g)) * 1024 + r;
    cre[i] = p.in[13][gi]; cim[i] = p.in[14][gi];
  }
  __syncthreads();
  {
    const int dir = tid >> 8, tau = (tid >> 4) & 15, pp = tid & 15;
    float sq[16];
#pragma unroll
    for (int q = 0; q < 16; ++q) sq[q] = 0.f;
    for (int n = 0; n < 64; ++n) {
      const float cr = cre[(dir * 16 + pp) * 64 + n], ci = cim[(dir * 16 + pp) * 64 + n];
      const float pr = pwre[(dir * 17 + tau) * 64 + n], pi = pwim[(dir * 17 + tau) * 64 + n];
      const float xr = cr * pr - ci * pi, xi = cr * pi + ci * pr;
      const LAS f32x4* br4 = (const LAS f32x4*)(bbre + (dir * 64 + n) * 16);
      const LAS f32x4* bi4 = (const LAS f32x4*)(bbim + (dir * 64 + n) * 16);
#pragma unroll
      for (int q4 = 0; q4 < 4; ++q4) { const f32x4 br = br4[q4], bi = bi4[q4];
#pragma unroll
        for (int j = 0; j < 4; ++j) sq[q4 * 4 + j] += xr * br[j] - xi * bi[j]; }
    }
#pragma unroll
    for (int q = 0; q < 16; ++q) (dir ? Kb : Kf)[tau * 256 + pp * 16 + q] = sq[q];
  }
  __syncthreads();
  bf16_t* EE = (bf16_t*)(p.ws + WS_EE) + (size_t)(l * 32 + g) * 256 * 256;
  for (int ch = tid; ch < 8192; ch += 512) {
    const int row = ch >> 5, c8 = (ch & 31) * 8, j = c8 >> 4, q0 = c8 & 15;
    const int dir = row >> 7, part = (row >> 6) & 1, n = row & 63;
    const int kp = dir ? j : 15 - j;
    const float pr = pwre[(dir * 17 + kp) * 64 + n], pi = pwim[(dir * 17 + kp) * 64 + n];
    float f[8];
#pragma unroll
    for (int e = 0; e < 8; ++e) {
      const float br = bbre[(dir * 64 + n) * 16 + q0 + e], bi = bbim[(dir * 64 + n) * 16 + q0 + e];
      f[e] = part ? (pr * bi + pi * br) : (pr * br - pi * bi);
    }
    u32x4 w; w.x = pk2(f[0], f[1]); w.y = pk2(f[2], f[3]); w.z = pk2(f[4], f[5]); w.w = pk2(f[6], f[7]);
    *(u32x4*)(EE + (size_t)row * 256 + c8) = w;
  }
  bf16_t* MF = (bf16_t*)(p.ws + WS_MF) + (size_t)(l * 32 + g) * 256 * 512;
  for (int ch = tid; ch < 16384; ch += 512) {
    const int row = ch >> 6, c8 = (ch & 63) * 8, i = row >> 4, pp = row & 15;
    float f[8];
    if (c8 < 256) {
      const int j = c8 >> 4, q0 = c8 & 15;
#pragma unroll
      for (int e = 0; e < 8; ++e) {
        const int q = q0 + e; float v = 0.f;
        if (i >= j) v += Kf[(i - j) * 256 + pp * 16 + q];
        if (j >= i) v += Kb[(j - i) * 256 + pp * 16 + q];
        if (i == j && pp == q) v += p.in[15][l * 512 + g * 16 + pp];
        f[e] = v;
      }
    } else {
#pragma unroll
      for (int e = 0; e < 8; ++e) {
        const int cc = c8 - 256 + e, dir = cc >> 7, part = (cc >> 6) & 1, n = cc & 63;
        const int kp = dir ? 16 - i : i + 1;
        const float cr = cre[(dir * 16 + pp) * 64 + n], ci = cim[(dir * 16 + pp) * 64 + n];
        const float pr = pwre[(dir * 17 + kp) * 64 + n], pi = pwim[(dir * 17 + kp) * 64 + n];
        f[e] = part ? -(cr * pi + ci * pr) : (cr * pr - ci * pi);
      }
    }
    u32x4 w; w.x = pk2(f[0], f[1]); w.y = pk2(f[2], f[3]); w.z = pk2(f[4], f[5]); w.w = pk2(f[6], f[7]);
    *(u32x4*)(MF + (size_t)row * 512 + c8) = w;
  }
  __syncthreads();
}

__device__ __forceinline__ void phase0(const Params& p, LAS unsigned char* lds, int tid, int G) {
  for (int su = blockIdx.x; su < 256; su += G) { if (su < 192) ada_unit(p, su, lds, tid); else s5mat_unit(p, su - 192, lds, tid); }
  {
    float* ropeA = (float*)(p.ws + WS_RA); float* ropeR = (float*)(p.ws + WS_RR);
    const int* pos = (const int*)p.in[2];
  }
  LAS float* scr = (LAS float*)lds;
  {
    f32x4 tb[4][2];
    const bool split = (G == 256);
    const int bx = blockIdx.x, nmine = split ? (bx < 192 ? 35 : 17) : (7808 - bx + G - 1) / G;
#define TR_UNIT(J) ((J) < nmine ? (split ? (bx < 192 ? (J) * 192 + bx : 6720 + (J) * 64 + (bx - 192)) : bx + (J) * G) : 7808)
    tr_load(p, TR_UNIT(0), tid, tb[0]); tr_load(p, TR_UNIT(1), tid, tb[1]); tr_load(p, TR_UNIT(2), tid, tb[2]);
    for (int jb = 0; jb < nmine; jb += 4) {
#pragma unroll
      for (int j = 0; j < 4; ++j) {
        tr_load(p, TR_UNIT(jb + j + 3), tid, tb[(j + 3) & 3]);
        tr_store(p, TR_UNIT(jb + j), tid, tb[j], scr);
      }
    }
#undef TR_UNIT
  }
}

__device__ __forceinline__ void norm_phase(const Params& p, int l, const float* xin, int tid, int G) {
  const int lane = tid & 63, wave = tid >> 6;
  bf16_t* H = (bf16_t*)(p.ws + WS_H);
  const float* ada = (const float*)(p.ws + WS_ADA) + (size_t)l * 16 * 6144;
  const float* nw = p.in[3] + l * 2048;
  const int stride = G * 8;
  const int* pos = (const int*)p.in[2];
  float* ropeA = (float*)(p.ws + WS_RA); float* ropeR = (float*)(p.ws + WS_RR);
  const float invr = powf(10000.0f, -(float)lane * (2.0f / 128.0f)), inva = powf(500000.0f, -(float)(lane & 15) * (2.0f / 32.0f));
  int row = blockIdx.x * 8 + wave;
  f32x4 v[8], vn[8];
  if (row < kT) {
#pragma unroll
    for (int i = 0; i < 8; ++i) v[i] = __builtin_nontemporal_load((const f32x4*)(xin + (size_t)row * 2048 + (i * 64 + lane) * 4));
  }
  for (; row < kT; row += stride) {
    const int nrow = row + stride;
    if (nrow < kT) {
#pragma unroll
      for (int i = 0; i < 8; ++i) vn[i] = __builtin_nontemporal_load((const f32x4*)(xin + (size_t)nrow * 2048 + (i * 64 + lane) * 4));
    }
    if (l == 0) {
      const float fpos = (float)pos[row];
      float sv, cv; sincosf(fpos * invr, &sv, &cv);
      f32x2 o; o.x = cv; o.y = sv; *(f32x2*)(ropeR + ((size_t)row * 64 + lane) * 2) = o;
      float sa, ca; sincosf(fpos * inva, &sa, &ca);
      if (lane < 16) { f32x2 oa; oa.x = ca; oa.y = sa; *(f32x2*)(ropeA + ((size_t)row * 16 + lane) * 2) = oa; }
    }
    const int b = row >> 11;
    float ss = 0.f;
#pragma unroll
    for (int i = 0; i < 8; ++i) ss += v[i][0] * v[i][0] + v[i][1] * v[i][1] + v[i][2] * v[i][2] + v[i][3] * v[i][3];
    ss = wave_sum(ss);
    const float rstd = rsqrtf(ss * (1.0f / 2048.0f) + 1e-6f);
    u32x2 ow[8];
#pragma unroll
    for (int i = 0; i < 8; ++i) {
      const int col = (i * 64 + lane) * 4;
      const f32x4 w4 = *(const f32x4*)(nw + col), sh = *(const f32x4*)(ada + (size_t)b * 6144 + col), sc = *(const f32x4*)(ada + (size_t)b * 6144 + 2048 + col);
      const f32x4 y = v[i] * rstd * w4 * (sc + 1.0f) + sh;
      ow[i].x = pk2(y[0], y[1]); ow[i].y = pk2(y[2], y[3]);
    }
#pragma unroll
    for (int i = 0; i < 8; ++i) *(u32x2*)(H + (size_t)row * 2048 + (i * 64 + lane) * 4) = ow[i];
#pragma unroll
    for (int i = 0; i < 8; ++i) v[i] = vn[i];
  }
}

__device__ __forceinline__ void unpack8(const u32x4 v, float (&f)[8]) { f[0] = bflo(v.x); f[1] = bfhi(v.x); f[2] = bflo(v.y); f[3] = bfhi(v.y); f[4] = bflo(v.z); f[5] = bfhi(v.z); f[6] = bflo(v.w); f[7] = bfhi(v.w); }
__device__ __forceinline__ u32x4 pack8(const float (&f)[8]) { u32x4 w; w.x = pk2(f[0], f[1]); w.y = pk2(f[2], f[3]); w.z = pk2(f[4], f[5]); w.w = pk2(f[6], f[7]); return w; }
__device__ __forceinline__ void prep_phase(const Params& p, int l, LAS unsigned char* lds, int tid, int G) {
  bf16_t* Z = (bf16_t*)(p.ws + WS_Z);
  bf16_t* AVT = (bf16_t*)(p.ws + WS_AVT);
  bf16_t* RKF = (bf16_t*)(p.ws + WS_RKF);
  bf16_t* RKB = (bf16_t*)(p.ws + WS_RKB);
  bf16_t* RVT = (bf16_t*)(p.ws + WS_RVT);
  const float* ropeA = (const float*)(p.ws + WS_RA);
  const float* ropeR = (const float*)(p.ws + WS_RR);
  const float* qn = p.in[18] + l * 128; const float* kn = p.in[19] + l * 128;
  const int c = tid & 15, rsub = tid >> 4;
  const float qs = 0.08838834764831845f;
  LAS bf16_t* tile = (LAS bf16_t*)lds;
  for (int unit = blockIdx.x; unit < 512; unit += G) {
    const int tok0 = unit * 64, b = tok0 >> 11;
    for (int kind = 1; kind < 2; ++kind) {
      float wn[8], wqf[8];
      { const f32x4 a = *(const f32x4*)(qn + 8 * c), bq = *(const f32x4*)(qn + 8 * c + 4);
        wqf[0] = a[0]; wqf[1] = a[1]; wqf[2] = a[2]; wqf[3] = a[3]; wqf[4] = bq[0]; wqf[5] = bq[1]; wqf[6] = bq[2]; wqf[7] = bq[3]; }
      { const f32x4 a = *(const f32x4*)((kind ? kn : qn) + 8 * c), bq = *(const f32x4*)((kind ? kn : qn) + 8 * c + 4);
        wn[0] = a[0]; wn[1] = a[1]; wn[2] = a[2]; wn[3] = a[3]; wn[4] = bq[0]; wn[5] = bq[1]; wn[6] = bq[2]; wn[7] = bq[3]; }
      const int nit = kind ? 4 : 16;
      for (int it0 = 0; it0 < nit; it0 += 4) {
        u32x4 vv[4]; f32x4 rr[4][4];
#pragma unroll
        for (int q = 0; q < 4; ++q) {
          const int R = (it0 + q) * 32 + rsub, hh = R >> 6, ts = R & 63, tok = tok0 + ts;
          vv[q] = *(const u32x4*)(Z + (size_t)tok * kINW + (kind ? ZC_AK : ZC_AQ) + hh * 128 + 8 * c);
          const float* rp = ropeA + ((size_t)tok * 16 + 8 * (c & 1)) * 2;
          rr[q][0] = *(const f32x4*)rp; rr[q][1] = *(const f32x4*)(rp + 4); rr[q][2] = *(const f32x4*)(rp + 8); rr[q][3] = *(const f32x4*)(rp + 12);
        }
#pragma unroll
        for (int q = 0; q < 4; ++q) {
          const int R = (it0 + q) * 32 + rsub, hh = R >> 6, ts = R & 63, tok = tok0 + ts;
          float f[8]; unpack8(vv[q], f);
          float ss = 0.f;
#pragma unroll
          for (int j = 0; j < 8; ++j) ss += f[j] * f[j];
          ss += __shfl_xor(ss, 1); ss += __shfl_xor(ss, 2); ss += __shfl_xor(ss, 4); ss += __shfl_xor(ss, 8);
          const float rstd = rsqrtf(ss * (1.0f / 128.0f) + 1e-6f);
          const f32x4 r0 = rr[q][0], r1 = rr[q][1], r2 = rr[q][2], r3 = rr[q][3];
          const float cs[8] = {r0[0], r0[2], r1[0], r1[2], r2[0], r2[2], r3[0], r3[2]};
          const float sn[8] = {r0[1], r0[3], r1[1], r1[3], r2[1], r2[3], r3[1], r3[3]};
          const float sgn = (c & 2) ? 1.0f : -1.0f;
#pragma unroll
          for (int j = 0; j < 8; ++j) {
            const float y = f[j] * rstd * wn[j];
            const float pr = __shfl_xor(y, 2);
            f[j] = (c < 4) ? (y * cs[j] + sgn * pr * sn[j]) : y * wqf[j];
          }
          *(u32x4*)(Z + (size_t)tok * kINW + (kind ? ZC_AK : ZC_AQ) + hh * 128 + 8 * c) = pack8(f);
        }
      }
    }
    for (int it0 = 0; it0 < 16; it0 += 4) {
      u32x4 vv[4]; f32x4 rr[4][4];
#pragma unroll
      for (int q = 0; q < 4; ++q) {
        const int R = (it0 + q) * 32 + rsub, hh = R >> 6, ts = R & 63, tok = tok0 + ts;
        vv[q] = *(const u32x4*)(Z + (size_t)tok * kINW + (hh < 4 ? ZC_RQ + hh * 128 : ZC_RK + (hh - 4) * 128) + 8 * c);
        const float* rp = ropeR + ((size_t)tok * 64 + 8 * (c & 7)) * 2;
        rr[q][0] = *(const f32x4*)rp; rr[q][1] = *(const f32x4*)(rp + 4); rr[q][2] = *(const f32x4*)(rp + 8); rr[q][3] = *(const f32x4*)(rp + 12);
      }
#pragma unroll
      for (int q = 0; q < 4; ++q) {
        const int R = (it0 + q) * 32 + rsub, hh = R >> 6, ts = R & 63, tok = tok0 + ts;
        float f[8]; unpack8(vv[q], f);
        const f32x4 r0 = rr[q][0], r1 = rr[q][1], r2 = rr[q][2], r3 = rr[q][3];
        const float cs[8] = {r0[0], r0[2], r1[0], r1[2], r2[0], r2[2], r3[0], r3[2]};
        const float sn[8] = {r0[1], r0[3], r1[1], r1[3], r2[1], r2[3], r3[1], r3[3]};
        const float sgn = (c & 8) ? 1.0f : -1.0f;
#pragma unroll
        for (int j = 0; j < 8; ++j) { const float pr = __shfl_xor(f[j], 8); f[j] = (f[j] * cs[j] + sgn * pr * sn[j]) * qs; }
        const u32x4 o = pack8(f);
        *(u32x4*)(Z + (size_t)tok * kINW + (hh < 4 ? ZC_RQ + hh * 128 : ZC_RK + (hh - 4) * 128) + 8 * c) = o;
      }
    }
  }
}

__device__ __forceinline__ void attn_phase(const Params& p, int l, LAS unsigned char* lds, int tid, int G) {
  const int lane = tid & 63, wave = tid >> 6, l31 = lane & 31, hh = lane >> 5;
  const bf16_t* Z = (const bf16_t*)(p.ws + WS_Z);
  const bf16_t* AVT = (const bf16_t*)(p.ws + WS_AVT);
  bf16_t* YC = (bf16_t*)(p.ws + WS_H);
  const float* qn = p.in[18] + l * 128; const float* kn = p.in[19] + l * 128; const float* sink = p.in[20] + l * 8;
  const float mq = wave_max(fmaxf(fabsf(qn[lane]), fabsf(qn[lane + 64]))), mk = wave_max(fmaxf(fabsf(kn[lane]), fabsf(kn[lane + 64])));
  const float smax = 11.313708499f * mq * mk * 1.01f + 0.1f;
  LAS unsigned char* Pw = lds + 69632 + wave * 4608;
  LAS float* Dn = (LAS float*)(lds + 69632 + 8 * 4608 + wave * 128);
  __syncthreads();
  const int vcu = (G % 8 == 0) ? ((int)blockIdx.x % 8) * (G / 8) + (int)blockIdx.x / 8 : (int)blockIdx.x;
  const int upb = (1024 + G - 1) / G;
  for (int ui = 0; ui < upb; ++ui) {
    const int unit = vcu * upb + ui;
    if (unit >= 1024) break;
    const int qb = unit & 31, kvh = (unit >> 5) & 1, b = unit >> 6;
    const int hq = kvh * 4 + (wave >> 1), q0 = qb * 64 + (wave & 1) * 32;
    const float sk = sink[hq] * 1.4426950408889634f, shift = fmaxf(smax * 1.4426950408889634f, sk);
    const bf16_t* qrow = Z + (size_t)(b * 2048 + q0 + l31) * kINW + ZC_AQ + hq * 128 + 8 * hh;
    bf16x8 Qf[8];
#pragma unroll
    for (int ks = 0; ks < 8; ++ks) Qf[ks] = ldg8(qrow + 16 * ks);
    {
      const float* rp = (const float*)(p.ws + WS_RA) + ((size_t)(b * 2048 + q0 + l31) * 16 + 8 * hh) * 2;
      const f32x4 r0 = *(const f32x4*)rp, r1 = *(const f32x4*)(rp + 4), r2 = *(const f32x4*)(rp + 8), r3 = *(const f32x4*)(rp + 12);
      const f32x4 wl0 = *(const f32x4*)(qn + 8 * hh), wl1 = *(const f32x4*)(qn + 8 * hh + 4), wh0 = *(const f32x4*)(qn + 16 + 8 * hh), wh1 = *(const f32x4*)(qn + 16 + 8 * hh + 4);
      float ssq = 0.f;
#pragma unroll
      for (int ks = 0; ks < 8; ++ks) { float f[8]; unpack8(__builtin_bit_cast(u32x4, Qf[ks]), f);
#pragma unroll
        for (int j = 0; j < 8; ++j) ssq += f[j] * f[j]; }
      ssq += __shfl_xor(ssq, 32);
      const float sc = rsqrtf(ssq * (1.0f / 128.0f) + 1e-6f) * (0.08838834764831845f * 1.4426950408889634f);
#pragma unroll
      for (int ks = 2; ks < 8; ++ks) { float f[8]; unpack8(__builtin_bit_cast(u32x4, Qf[ks]), f);
#pragma unroll
        for (int j = 0; j < 8; ++j) f[j] *= sc;
        Qf[ks] = __builtin_bit_cast(bf16x8, pack8(f)); }
      float x1[8], x2[8]; unpack8(__builtin_bit_cast(u32x4, Qf[0]), x1); unpack8(__builtin_bit_cast(u32x4, Qf[1]), x2);
      const float cs[8] = {r0[0], r0[2], r1[0], r1[2], r2[0], r2[2], r3[0], r3[2]};
      const float sn[8] = {r0[1], r0[3], r1[1], r1[3], r2[1], r2[3], r3[1], r3[3]};
      const float wl[8] = {wl0[0], wl0[1], wl0[2], wl0[3], wl1[0], wl1[1], wl1[2], wl1[3]};
      const float wh[8] = {wh0[0], wh0[1], wh0[2], wh0[3], wh1[0], wh1[1], wh1[2], wh1[3]};
#pragma unroll
      for (int j = 0; j < 8; ++j) { const float a = x1[j] * sc * wl[j], bq = x2[j] * sc * wh[j]; x1[j] = a * cs[j] - bq * sn[j]; x2[j] = bq * cs[j] + a * sn[j]; }
      Qf[0] = __builtin_bit_cast(bf16x8, pack8(x1)); Qf[1] = __builtin_bit_cast(bf16x8, pack8(x2));
    }
    f32x16 O[4];
#pragma unroll
    for (int nt = 0; nt < 4; ++nt) O[nt] = zero16();
    float lsum = 0.f;
    const int qpos = q0 + l31;
    const int kt_lo = qb >= 2 ? 0 : 2 - qb, kt_hi = (33 - qb) < 4 ? (33 - qb) : 4;
    const int kr_ = tid >> 4, kc8 = (tid & 15) * 8;
    const bf16_t* kgp = Z + (long)(b * 2048 + qb * 64 - 128 + kr_) * (long)kINW + ZC_AK + kvh * 128 + kc8;
    const bf16_t* vgp = kgp + (ZC_AV - ZC_AK);
    u32x4 kreg[2], vreg[2];
#pragma unroll
    for (int i = 0; i < 2; ++i) { kreg[i] = *(const u32x4*)(kgp + (long)(kt_lo * 64 + i * 32) * (long)kINW); vreg[i] = *(const u32x4*)(vgp + (long)(kt_lo * 64 + i * 32) * (long)kINW); }
#pragma unroll
    for (int i = 0; i < 2; ++i) { *(LAS u32x4*)(lds + ((kr_ + i * 32) * 136 + kc8) * 2) = kreg[i]; *(LAS u32x4*)(lds + 17408 + ((kr_ + i * 32) * 136 + kc8) * 2) = vreg[i]; }
    if (kt_lo < kt_hi) {
#pragma unroll
      for (int i = 0; i < 2; ++i) { kreg[i] = *(const u32x4*)(kgp + (long)((kt_lo + 1) * 64 + i * 32) * (long)kINW); vreg[i] = *(const u32x4*)(vgp + (long)((kt_lo + 1) * 64 + i * 32) * (long)kINW); }
    }
    __syncthreads();
    for (int kt = kt_lo; kt <= kt_hi; ++kt) {
      const int key0 = qb * 64 - 128 + kt * 64;
      LAS unsigned char* Ks = lds + ((kt - kt_lo) & 1) * 34816;
      LAS unsigned char* Vs = Ks + 17408;
      f32x16 St[2]; St[0] = zero16(); St[1] = zero16();
#pragma unroll
      for (int ks = 0; ks < 8; ++ks)
#pragma unroll
        for (int mt = 0; mt < 2; ++mt) St[mt] = mfma32(lds8(Ks + ((32 * mt + l31) * 136 + 16 * ks + 8 * hh) * 2), Qf[ks], St[mt]);
      if (kt == 0 || kt == 4) {
#pragma unroll
        for (int mt = 0; mt < 2; ++mt)
#pragma unroll
          for (int r = 0; r < 16; ++r) {
            const int key = key0 + 32 * mt + (r & 3) + 8 * (r >> 2) + 4 * hh, dlt = key - qpos;
            const float pv = (dlt <= 128 && dlt >= -128) ? __builtin_amdgcn_exp2f(St[mt][r] - shift) : 0.f;
            lsum += pv; St[mt][r] = pv;
          }
      } else {
#pragma unroll
        for (int mt = 0; mt < 2; ++mt)
#pragma unroll
          for (int r = 0; r < 16; ++r) { const float pv = __builtin_amdgcn_exp2f(St[mt][r] - shift); lsum += pv; St[mt][r] = pv; }
      }
#pragma unroll
      for (int mt = 0; mt < 2; ++mt)
#pragma unroll
        for (int g4 = 0; g4 < 4; ++g4) {
          u32x2 w; w.x = pk2(St[mt][4 * g4], St[mt][4 * g4 + 1]); w.y = pk2(St[mt][4 * g4 + 2], St[mt][4 * g4 + 3]);
          *(LAS u32x2*)(Pw + (l31 * 72 + 32 * mt + 8 * g4 + 4 * hh) * 2) = w;
        }
#pragma unroll
      for (int ks = 0; ks < 4; ++ks) {
        const bf16x8 a = lds8(Pw + (l31 * 72 + 16 * ks + 8 * hh) * 2);
        const unsigned vbase = (unsigned)(size_t)Vs + (unsigned)(((16 * ks + 8 * hh + ((lane & 15) >> 2)) * 136 + 16 * ((lane >> 4) & 1) + 4 * (lane & 3)) * 2);
        u16x4 tr[8];
        TR_READ8(tr, vbase, 0, 1088, 64, 1152, 128, 1216, 192, 1280);
#pragma unroll
        for (int nt = 0; nt < 4; ++nt) O[nt] = mfma32(a, tr_join(tr[2 * nt], tr[2 * nt + 1]), O[nt]);
      }
      if (kt < kt_hi) {
        LAS unsigned char* Kn = lds + ((kt + 1 - kt_lo) & 1) * 34816;
#pragma unroll
        for (int i = 0; i < 2; ++i) { *(LAS u32x4*)(Kn + ((kr_ + i * 32) * 136 + kc8) * 2) = kreg[i]; *(LAS u32x4*)(Kn + 17408 + ((kr_ + i * 32) * 136 + kc8) * 2) = vreg[i]; }
        if (kt + 1 < kt_hi) {
#pragma unroll
          for (int i = 0; i < 2; ++i) { kreg[i] = *(const u32x4*)(kgp + (long)((kt + 2) * 64 + i * 32) * (long)kINW); vreg[i] = *(const u32x4*)(vgp + (long)((kt + 2) * 64 + i * 32) * (long)kINW); }
        }
      }
      __syncthreads();
    }
    lsum += __shfl_xor(lsum, 32);
    const float denom = lsum + exp2f(sk - shift);
    if (lane < 32) Dn[lane] = 1.0f / denom;
#pragma unroll
    for (int g4 = 0; g4 < 4; ++g4) {
      const f32x4 inv4 = *(LAS f32x4*)(Dn + 8 * g4 + 4 * hh);
      bf16_t gts[4][4];
#pragma unroll
      for (int j = 0; j < 4; ++j)
#pragma unroll
        for (int nt = 0; nt < 4; ++nt) gts[j][nt] = Z[(size_t)(b * 2048 + q0 + 8 * g4 + 4 * hh + j) * kINW + ZC_AG + hq * 128 + 32 * nt + l31];
#pragma unroll
      for (int j = 0; j < 4; ++j)
#pragma unroll
        for (int nt = 0; nt < 4; ++nt)
          YC[(size_t)(b * 2048 + q0 + 8 * g4 + 4 * hh + j) * 2048 + 512 + hq * 128 + 32 * nt + l31] = (bf16_t)f2bf(O[nt][4 * g4 + j] * inv4[j] * bf2f(gts[j][nt]));
    }
  }
}

__device__ __forceinline__ void retstate_phase(const Params& p, LAS unsigned char* lds, int tid, int G) {
  const int lane = tid & 63, wave = tid >> 6, l31 = lane & 31, hh = lane >> 5;
  const bf16_t* Z = (const bf16_t*)(p.ws + WS_Z);
  const int er = wave >> 2, dc = wave & 3;
  const int sr = tid >> 4, sc8 = (tid & 15) * 8;
  const int vr = tid >> 3, vc8 = (tid & 7) * 8;
  const int trq = (lane & 15) >> 2, trb = (lane >> 4) & 1, trp = lane & 3;
  for (int unit = blockIdx.x; unit < 256; unit += G) {
    const int eh = unit & 1, dir = (unit >> 1) & 1, h = (unit >> 2) & 3, b = unit >> 4;
    const float lg = lgam2(h);
    const float gch = exp2f(128.0f * lg);
    const bf16_t* kb = Z + ((size_t)b * 2048 + sr) * kINW + ZC_RK + h * 128 + sc8;
    const bf16_t* vb = Z + ((size_t)b * 2048 + vr) * kINW + ZC_RV + h * 128 + 64 * eh + vc8;
    bf16_t* S = (bf16_t*)(p.ws + (dir ? WS_SF : WS_SP));
    const int e = 64 * eh + 32 * er + l31;
    float wk[4];
#pragma unroll
    for (int i = 0; i < 4; ++i) { const int j = sr + 32 * i; wk[i] = exp2f(lg * (float)(dir ? j : 127 - j)); }
    f32x16 acc = zero16();
    u32x4 r0k[4], r0v[2], r1k[4], r1v[2];
#define RS_LOAD(RK, RV, ST) do { const int n_ = dir ? 15 - (ST) : (ST); \
      _Pragma("unroll") for (int i = 0; i < 4; ++i) RK[i] = *(const u32x4*)(kb + (size_t)(n_ * 128 + i * 32) * kINW); \
      _Pragma("unroll") for (int i = 0; i < 2; ++i) RV[i] = *(const u32x4*)(vb + (size_t)(n_ * 128 + i * 64) * kINW); } while (0)
#define RS_STEP(RK, RV, BUF, ST) do { \
      LAS unsigned char* Kt = lds + (BUF) * 69632; LAS unsigned char* Vt = Kt + 34816; \
      _Pragma("unroll") for (int i = 0; i < 4; ++i) { float f_[8]; unpack8(RK[i], f_); _Pragma("unroll") for (int j = 0; j < 8; ++j) f_[j] *= wk[i]; \
        *(LAS u32x4*)(Kt + ((sr + 32 * i) * 136 + sc8) * 2) = pack8(f_); } \
      _Pragma("unroll") for (int i = 0; i < 2; ++i) *(LAS u32x4*)(Vt + ((vr + 64 * i) * 136 + vc8) * 2) = RV[i]; \
      __syncthreads(); \
      if ((ST) + 2 < 16) RS_LOAD(RK, RV, (ST) + 2); \
      const int n = dir ? 15 - (ST) : (ST); \
      bf16_t* so = S + (((size_t)(b * 4 + h) * 16 + n) * 128 + e) * 128 + 32 * dc + 4 * hh; \
      _Pragma("unroll") for (int g4 = 0; g4 < 4; ++g4) { u32x2 w; w.x = pk2(acc[4 * g4], acc[4 * g4 + 1]); w.y = pk2(acc[4 * g4 + 2], acc[4 * g4 + 3]); *(u32x2*)(so + 8 * g4) = w; } \
      _Pragma("unroll") for (int r = 0; r < 16; ++r) acc[r] *= gch; \
      const unsigned ka_ = (unsigned)(size_t)Kt + (unsigned)(((8 * hh + trq) * 136 + 32 * dc + 16 * trb + 4 * trp) * 2); \
      const unsigned va_ = (unsigned)(size_t)Vt + (unsigned)(((8 * hh + trq) * 136 + 32 * er + 16 * trb + 4 * trp) * 2); \
      _Pragma("unroll") for (int k4 = 0; k4 < 2; ++k4) { u16x4 ta[8], tb[8]; \
        TR_READ8(ta, ka_ + k4 * 17408, 0, 1088, 4352, 5440, 8704, 9792, 13056, 14144); \
        TR_READ8(tb, va_ + k4 * 17408, 0, 1088, 4352, 5440, 8704, 9792, 13056, 14144); \
        _Pragma("unroll") for (int ks = 0; ks < 4; ++ks) acc = mfma32(tr_join(ta[2 * ks], ta[2 * ks + 1]), tr_join(tb[2 * ks], tb[2 * ks + 1]), acc); } } while (0)
    RS_LOAD(r0k, r0v, 0); RS_LOAD(r1k, r1v, 1);
    __syncthreads();
#pragma unroll 1
    for (int st = 0; st < 16; st += 2) { RS_STEP(r0k, r0v, 0, st); RS_STEP(r1k, r1v, 1, st + 1); }
#undef RS_STEP
#undef RS_LOAD
  }
}

__device__ __forceinline__ void retout_phase(const Params& p, int l, LAS unsigned char* lds, int tid, int G) {
  const int lane = tid & 63, wave = tid >> 6, l31 = lane & 31, hh = lane >> 5;
  const bf16_t* Z = (const bf16_t*)(p.ws + WS_Z);
  const bf16_t* RVT = (const bf16_t*)(p.ws + WS_RVT);
  const bf16_t* SP = (const bf16_t*)(p.ws + WS_SP); const bf16_t* SF = (const bf16_t*)(p.ws + WS_SF);
  bf16_t* YC = (bf16_t*)(p.ws + WS_H);
  const float* gnw = p.in[21] + l * 512;
  LAS unsigned char* R0 = lds;
  LAS unsigned char* R1 = lds + 34816;
  LAS unsigned char* R2 = lds + 69632;
  LAS unsigned char* R3 = lds + 104448;
  LAS float* Of = (LAS float*)lds;
  const int ri = wave >> 1, hf = wave & 1;
  const int sr = tid >> 4, sc8 = (tid & 15) * 8;
  for (int unit = blockIdx.x; unit < 1024; unit += G) {
    const int h = unit & 3, n = (unit >> 2) & 15, b = unit >> 6;
    const size_t tokb = (size_t)b * 2048 + n * 128;
    const float lg2 = lgam2(h);
    u32x4 tq[4], tk[4], tv[4], tp[4], tf[4];
#pragma unroll
    for (int i = 0; i < 4; ++i) {
      const int row = sr + 32 * i;
      tq[i] = *(const u32x4*)(Z + (tokb + row) * kINW + ZC_RQ + h * 128 + sc8);
      tk[i] = *(const u32x4*)(Z + (tokb + row) * kINW + ZC_RK + h * 128 + sc8);
      tv[i] = *(const u32x4*)(Z + (tokb + row) * kINW + ZC_RV + h * 128 + sc8);
    }
    __syncthreads();
#pragma unroll
    for (int i = 0; i < 4; ++i) {
      const int off = ((sr + 32 * i) * 136 + sc8) * 2;
      *(LAS u32x4*)(R0 + off) = tq[i]; *(LAS u32x4*)(R1 + off) = tk[i]; *(LAS u32x4*)(R3 + off) = tv[i];
    }
#pragma unroll
    for (int i = 0; i < 4; ++i) {
      const int row = sr + 32 * i;
      tp[i] = *(const u32x4*)(SP + (((size_t)(b * 4 + h) * 16 + n) * 128 + row) * 128 + sc8);
      tf[i] = *(const u32x4*)(SF + (((size_t)(b * 4 + h) * 16 + n) * 128 + row) * 128 + sc8);
    }
    __syncthreads();
    const int iq = 32 * ri + l31;
    bf16x8 Qf[8];
#pragma unroll
    for (int ks = 0; ks < 8; ++ks) Qf[ks] = lds8(R0 + (iq * 136 + 16 * ks + 8 * hh) * 2);
#pragma unroll
    for (int mt = 0; mt < 2; ++mt) {
      f32x16 acc = zero16();
#pragma unroll
      for (int ks = 0; ks < 8; ++ks) acc = mfma32(lds8(R1 + ((64 * hf + 32 * mt + l31) * 136 + 16 * ks + 8 * hh) * 2), Qf[ks], acc);
#pragma unroll
      for (int g4 = 0; g4 < 4; ++g4) {
        const int j0 = 64 * hf + 32 * mt + 8 * g4 + 4 * hh;
        float v[4];
#pragma unroll
        for (int jj = 0; jj < 4; ++jj) { const int dl = iq - (j0 + jj); v[jj] = acc[4 * g4 + jj] * __builtin_amdgcn_exp2f(lg2 * (float)(dl < 0 ? -dl : dl)); }
        u32x2 w; w.x = pk2(v[0], v[1]); w.y = pk2(v[2], v[3]);
        *(LAS u32x2*)(R2 + (iq * 136 + j0) * 2) = w;
      }
    }
    __syncthreads();
#pragma unroll
    for (int i = 0; i < 4; ++i) *(LAS u32x4*)(R1 + ((sr + 32 * i) * 136 + sc8) * 2) = tp[i];
    __syncthreads();
    f32x16 acc[2]; acc[0] = zero16(); acc[1] = zero16();
#pragma unroll
    for (int nt = 0; nt < 2; ++nt)
#pragma unroll
      for (int ks = 0; ks < 8; ++ks) acc[nt] = mfma32(Qf[ks], lds8(R1 + ((64 * hf + 32 * nt + l31) * 136 + 16 * ks + 8 * hh) * 2), acc[nt]);
#pragma unroll
    for (int r = 0; r < 16; ++r) {
      const int il = 32 * ri + (r & 3) + 8 * (r >> 2) + 4 * hh;
      const float rt = exp2f(lg2 * (float)(2 * il + 1 - 128));
      acc[0][r] *= rt; acc[1][r] *= rt;
    }
    __syncthreads();
#pragma unroll
    for (int i = 0; i < 4; ++i) *(LAS u32x4*)(R1 + ((sr + 32 * i) * 136 + sc8) * 2) = tf[i];
    __syncthreads();
#pragma unroll
    for (int nt = 0; nt < 2; ++nt)
#pragma unroll
      for (int ks = 0; ks < 8; ++ks) acc[nt] = mfma32(Qf[ks], lds8(R1 + ((64 * hf + 32 * nt + l31) * 136 + 16 * ks + 8 * hh) * 2), acc[nt]);
#pragma unroll
    for (int r = 0; r < 16; ++r) {
      const int il = 32 * ri + (r & 3) + 8 * (r >> 2) + 4 * hh;
      const float fw = exp2f(lg2 * (float)(128 - il));
      acc[0][r] *= fw; acc[1][r] *= fw;
    }
#pragma unroll
    for (int m2 = 0; m2 < 4; ++m2) {
      const unsigned vbase = (unsigned)(size_t)R3 + (unsigned)(((32 * m2 + 8 * hh + ((lane & 15) >> 2)) * 136 + 64 * hf + 16 * ((lane >> 4) & 1) + 4 * (lane & 3)) * 2);
      u16x4 tr[8];
      TR_READ8(tr, vbase, 0, 1088, 64, 1152, 4352, 5440, 4416, 5504);
#pragma unroll
      for (int k2 = 0; k2 < 2; ++k2) {
        const bf16x8 a = lds8(R2 + (iq * 136 + 16 * (2 * m2 + k2) + 8 * hh) * 2);
#pragma unroll
        for (int nt = 0; nt < 2; ++nt) acc[nt] = mfma32(a, tr_join(tr[4 * k2 + 2 * nt], tr[4 * k2 + 2 * nt + 1]), acc[nt]);
      }
    }
    __syncthreads();
#pragma unroll
    for (int nt = 0; nt < 2; ++nt)
#pragma unroll
      for (int r = 0; r < 16; ++r) Of[(32 * ri + (r & 3) + 8 * (r >> 2) + 4 * hh) * 132 + 64 * hf + 32 * nt + l31] = acc[nt][r];
    __syncthreads();
    {
      const int c = lane & 15, rs4 = lane >> 4;
      float wn[8];
      { const f32x4 a = *(const f32x4*)(gnw + h * 128 + 8 * c), bq = *(const f32x4*)(gnw + h * 128 + 8 * c + 4);
        wn[0] = a[0]; wn[1] = a[1]; wn[2] = a[2]; wn[3] = a[3]; wn[4] = bq[0]; wn[5] = bq[1]; wn[6] = bq[2]; wn[7] = bq[3]; }
      u32x4 gv[4], ov[4];
#pragma unroll
      for (int ps = 0; ps < 4; ++ps) gv[ps] = *(const u32x4*)(Z + (tokb + 16 * wave + 4 * ps + rs4) * kINW + ZC_RG + h * 128 + 8 * c);
#pragma unroll
      for (int ps = 0; ps < 4; ++ps) {
        const int row = 16 * wave + 4 * ps + rs4;
        const f32x4 x0 = *(const LAS f32x4*)(Of + row * 132 + 8 * c), x1 = *(const LAS f32x4*)(Of + row * 132 + 8 * c + 4);
        float f[8] = {x0[0], x0[1], x0[2], x0[3], x1[0], x1[1], x1[2], x1[3]};
        float sm = 0.f;
#pragma unroll
        for (int j = 0; j < 8; ++j) sm += f[j];
        sm += __shfl_xor(sm, 1); sm += __shfl_xor(sm, 2); sm += __shfl_xor(sm, 4); sm += __shfl_xor(sm, 8);
        const float mu = sm * (1.0f / 128.0f);
        float vs = 0.f;
#pragma unroll
        for (int j = 0; j < 8; ++j) { f[j] -= mu; vs += f[j] * f[j]; }
        vs += __shfl_xor(vs, 1); vs += __shfl_xor(vs, 2); vs += __shfl_xor(vs, 4); vs += __shfl_xor(vs, 8);
        const float rs = rsqrtf(vs * (1.0f / 128.0f) + 1e-6f);
        float fg[8]; unpack8(gv[ps], fg);
#pragma unroll
        for (int j = 0; j < 8; ++j) f[j] = f[j] * rs * wn[j] * fg[j];
        ov[ps] = pack8(f);
      }
#pragma unroll
      for (int ps = 0; ps < 4; ++ps) *(u32x4*)(YC + (tokb + 16 * wave + 4 * ps + rs4) * 2048 + 1536 + h * 128 + 8 * c) = ov[ps];
    }
  }
}

__device__ __forceinline__ void s5_phase(const Params& p, int l, LAS unsigned char* lds, int tid, int G) {
  const int lane = tid & 63, wave = tid >> 6, l31 = lane & 31, hh = lane >> 5;
  const bf16_t* Z = (const bf16_t*)(p.ws + WS_Z);
  bf16_t* YS = (bf16_t*)(p.ws + WS_YS);
  LAS unsigned char* Us = lds;
  LAS float* Hc = (LAS float*)(lds + 67584);
  for (int unit = blockIdx.x; unit < 512; unit += G) {
    const int g = unit & 31, b = unit >> 5;
    const bf16_t* EEp = (const bf16_t*)(p.ws + WS_EE) + (size_t)(l * 32 + g) * 65536;
    const bf16_t* MFp = (const bf16_t*)(p.ws + WS_MF) + (size_t)(l * 32 + g) * 131072;
    const bf16_t* mrow = MFp + (32 * wave + l31) * 512 + 8 * hh;
    __syncthreads();
    {
      u32x4 uv[8];
#pragma unroll
      for (int i = 0; i < 8; ++i) { const int idx = tid + 512 * i, tok = idx >> 1, half = idx & 1; uv[i] = *(const u32x4*)(Z + (size_t)(b * 2048 + tok) * kINW + g * 16 + half * 8); }
#pragma unroll
      for (int i = 0; i < 8; ++i) { const int idx = tid + 512 * i, tok = idx >> 1, half = idx & 1; *(LAS u32x4*)(Us + (tok >> 4) * 528 + (tok & 15) * 32 + half * 16) = uv[i]; }
    }
    __syncthreads();
    f32x16 acc[4];
#pragma unroll
    for (int nt = 0; nt < 4; ++nt) acc[nt] = zero16();
#pragma unroll 1
    for (int dir = 0; dir < 2; ++dir) {
      {
        const int rt = wave >> 1, ct0 = (wave & 1) * 2;
        f32x16 a2[2]; a2[0] = zero16(); a2[1] = zero16();
        const bf16_t* arow = EEp + (dir * 128 + 32 * rt + l31) * 256 + 8 * hh;
#pragma unroll
        for (int ks = 0; ks < 16; ++ks) {
          const bf16x8 a = ldg8(arow + 16 * ks);
#pragma unroll
          for (int t2 = 0; t2 < 2; ++t2) a2[t2] = mfma32(a, lds8(Us + (32 * (ct0 + t2) + l31) * 528 + ks * 32 + hh * 16), a2[t2]);
        }
#pragma unroll
        for (int t2 = 0; t2 < 2; ++t2)
#pragma unroll
          for (int g4 = 0; g4 < 4; ++g4) {
            f32x4 v; v[0] = a2[t2][4 * g4]; v[1] = a2[t2][4 * g4 + 1]; v[2] = a2[t2][4 * g4 + 2]; v[3] = a2[t2][4 * g4 + 3];
            *(LAS f32x4*)(Hc + (32 * (ct0 + t2) + l31) * 132 + 32 * rt + 8 * g4 + 4 * hh) = v;
          }
      }
      __syncthreads();
      if (wave == 0) {
        const float* a16 = (const float*)(p.ws + WS_A16) + ((size_t)((l * 32 + g) * 2 + dir) * 64 + lane) * 2;
        const float ar = a16[0], ai = a16[1];
        float cr = 0.f, ci = 0.f;
        for (int c8 = 0; c8 < 16; ++c8) {
          float hr[8], hi[8];
#pragma unroll
          for (int j = 0; j < 8; ++j) { const int c = dir ? 127 - (c8 * 8 + j) : c8 * 8 + j; hr[j] = Hc[c * 132 + lane]; hi[j] = Hc[c * 132 + 64 + lane]; }
#pragma unroll
          for (int j = 0; j < 8; ++j) {
            const int c = dir ? 127 - (c8 * 8 + j) : c8 * 8 + j;
            Hc[c * 132 + lane] = cr; Hc[c * 132 + 64 + lane] = ci;
            const float nr = ar * cr - ai * ci + hr[j], ni = ar * ci + ai * cr + hi[j];
            cr = nr; ci = ni;
          }
        }
      }
      if (dir == 0) {
        for (int ks = 0; ks < 16; ++ks) {
          const bf16x8 a = ldg8(mrow + 16 * ks);
#pragma unroll
          for (int nt = 0; nt < 4; ++nt) acc[nt] = mfma32(a, lds8(Us + (32 * nt + l31) * 528 + ks * 32 + hh * 16), acc[nt]);
        }
      }
      __syncthreads();
      for (int ks = 0; ks < 8; ++ks) {
        const bf16x8 a = ldg8(mrow + 256 + dir * 128 + 16 * ks);
#pragma unroll
        for (int nt = 0; nt < 4; ++nt) {
          const LAS float* cp = Hc + (32 * nt + l31) * 132 + 16 * ks + 8 * hh;
          const f32x4 c0 = *(const LAS f32x4*)cp, c1 = *(const LAS f32x4*)(cp + 4);
          u32x4 w; w.x = pk2(c0[0], c0[1]); w.y = pk2(c0[2], c0[3]); w.z = pk2(c1[0], c1[1]); w.w = pk2(c1[2], c1[3]);
          acc[nt] = mfma32(a, __builtin_bit_cast(bf16x8, w), acc[nt]);
        }
      }
      __syncthreads();
    }
#pragma unroll
    for (int nt = 0; nt < 4; ++nt)
#pragma unroll
      for (int g4 = 0; g4 < 4; ++g4) {
        const int row0 = 32 * wave + 8 * g4 + 4 * hh, i = row0 >> 4, p0 = row0 & 15, c = 32 * nt + l31;
        const size_t tok = (size_t)b * 2048 + 16 * c + i;
        u32x2 w; w.x = pk2(gelu_tanh_f(acc[nt][4 * g4]), gelu_tanh_f(acc[nt][4 * g4 + 1])); w.y = pk2(gelu_tanh_f(acc[nt][4 * g4 + 2]), gelu_tanh_f(acc[nt][4 * g4 + 3]));
        *(u32x2*)(YS + tok * 512 + g * 16 + p0) = w;
      }
  }
}

extern __shared__ __attribute__((aligned(16))) unsigned char dyn_lds[];
__global__ void __launch_bounds__(512, 2) mega(Params p) {
  cg::grid_group grid = cg::this_grid();
  LAS unsigned char* lds = (LAS unsigned char*)dyn_lds;
  volatile LAS unsigned* bst = (volatile LAS unsigned*)(lds + kLdsBytes - 64);
  if (threadIdx.x < 16) bst[threadIdx.x] = 0u;
  __syncthreads();
  (void)xcd_barrier_post((unsigned*)(p.ws + WS_CTL), bst);
#define GSYNC() do { XcdBarrier xb_; xb_.bar = (unsigned*)(p.ws + WS_CTL); xb_.x = xb_xcc_id(); xb_.st = bst; xcd_barrier(xb_); } while (0)
  const int G = gridDim.x;
#define tid opaque_tid()
#define WSL() ({ Params q_ = p; __attribute__((address_space(1))) unsigned char* g_ = (__attribute__((address_space(1))) unsigned char*)q_.ws; asm volatile("" : "+s"(g_)); q_.ws = (unsigned char*)g_; q_; })
#ifndef PHMASK
#define PHMASK 0xFFFF
#endif
#ifndef REPMASK
#define REPMASK 0
#endif
#ifndef XSYNC
#define XSYNC 0
#endif
#if PHMASK & 1
  phase0(WSL(), lds, tid, G);
#if REPMASK & 1
  phase0(WSL(), lds, tid, G);
#endif
#endif
  if (p.ws == nullptr) grid.sync();
  GSYNC();
  for (int l = 0; l < 2; ++l) {
    const float* xin = l == 0 ? p.in[0] : p.out;
#if PHMASK & 2
    norm_phase(WSL(), l, xin, tid, G);
#if REPMASK & 2
    norm_phase(WSL(), l, xin, tid, G);
#endif
#endif
    GSYNC();
#if PHMASK & 4
    {
      const Params q = WSL();
      pg8::Gemm g{(const bf16_t*)(q.ws + WS_H), (const bf16_t*)(q.ws + WS_WIN) + (size_t)l * 5632 * 2048, kT, kINW, 2048};
      pg8::StaticOrder S; S.init(kT, kINW, G, (int)blockIdx.x);
      EpiZ E{(bf16_t*)(q.ws + WS_Z)};
      pg8::gemm_phase<EpiZ, pg8::StaticOrder, true, true>(lds, g, S, E);
#if REPMASK & 4
      pg8::gemm_phase<EpiZ, pg8::StaticOrder, true, true>(lds, g, S, E);
#endif
    }
#endif
    GSYNC();
#if PHMASK & 8
    prep_phase(WSL(), l, lds, tid, G);
#endif
    GSYNC();
#if PHMASK & 16
    attn_phase(WSL(), l, lds, tid, G);
#if REPMASK & 16
    attn_phase(WSL(), l, lds, tid, G);
#endif
#endif
#if PHMASK & 32
    retstate_phase(WSL(), lds, tid, G);
#if REPMASK & 32
    retstate_phase(WSL(), lds, tid, G);
#endif
#endif
#if PHMASK & 64
    s5_phase(WSL(), l, lds, tid, G);
#if REPMASK & 64
    s5_phase(WSL(), l, lds, tid, G);
#endif
#endif
    GSYNC();
#if PHMASK & 256
    {
      const Params q = WSL();
      pg8::Gemm g{(const bf16_t*)(q.ws + WS_YS), (const bf16_t*)(q.ws + WS_GLU) + (size_t)l * 512 * 512, kT, 512, 512};
      pg8::StaticOrder S; S.init(kT, 512, G, (int)blockIdx.x);
      EpiGlu E{(const bf16_t*)(q.ws + WS_YS), (const bf16_t*)(q.ws + WS_Z), q.in[17] + l * 512, (bf16_t*)(q.ws + WS_H)};
      __syncthreads();
      pg8::gemm_phase<EpiGlu, pg8::StaticOrder, true, true>(lds, g, S, E);
#if REPMASK & 256
      pg8::gemm_phase<EpiGlu, pg8::StaticOrder, true, true>(lds, g, S, E);
#endif
    }
#endif
    __syncthreads();
#if PHMASK & 512
    retout_phase(WSL(), l, lds, tid, G);
#if REPMASK & 512
    retout_phase(WSL(), l, lds, tid, G);
#endif
#endif
    GSYNC();
#if PHMASK & 1024
    {
      const Params q = WSL();
      pg8::Gemm g{(const bf16_t*)(q.ws + WS_H), (const bf16_t*)(q.ws + WS_WOUT) + (size_t)l * 2048 * 2048, kT, 2048, 2048};
      pg8::StaticOrder S; S.init(kT, 2048, G, (int)blockIdx.x);
      EpiOut E{xin, q.out, (const float*)(q.ws + WS_ADA) + (size_t)l * 16 * 6144 + 4096};
      __syncthreads();
      pg8::gemm_phase<EpiOut, pg8::StaticOrder, true, true>(lds, g, S, E);
#if REPMASK & 1024
      if (l == 0) pg8::gemm_phase<EpiOut, pg8::StaticOrder, true, true>(lds, g, S, E);
#endif
    }
#endif
    GSYNC();
    for (int xs = 0; xs < XSYNC; ++xs) GSYNC();
  }
#undef tid
#undef WSL
}

extern "C" void kernel_launch(void* const* d_in, const int* in_sizes, int n_in, void* d_out, int out_size, void* d_ws, size_t ws_size, hipStream_t stream) {
  static int grid_blocks = 0;
  if (grid_blocks == 0) {
    if (n_in != 22 || ws_size < WS_END) { fprintf(stderr, "kernel_launch: unexpected n_in %d or ws_size %zu (need %zu)\n", n_in, ws_size, (size_t)WS_END); grid_blocks = -1; return; }
    int dev = 0, cus = 0, per_cu = 0;
    (void)hipGetDevice(&dev);
    (void)hipDeviceGetAttribute(&cus, hipDeviceAttributeMultiprocessorCount, dev);
    (void)hipFuncSetAttribute((const void*)mega, hipFuncAttributeMaxDynamicSharedMemorySize, kLdsBytes);
    (void)hipOccupancyMaxActiveBlocksPerMultiprocessor(&per_cu, (const void*)mega, 512, kLdsBytes);
    if (per_cu < 1) fprintf(stderr, "kernel_launch: occupancy query says %d blocks per CU\n", per_cu);
    (void)hipGetLastError();
    grid_blocks = cus;
  }
  if (grid_blocks < 0) return;
  (void)hipMemsetAsync((unsigned char*)d_ws + WS_CTL, 0, CTL_BYTES, stream);
  Params p{};
  for (int i = 0; i < 22; ++i) p.in[i] = (const float*)d_in[i];
  p.out = (float*)d_out; p.ws = (unsigned char*)d_ws;
  void* args[] = {&p};
  hipError_t e = hipLaunchCooperativeKernel((void*)mega, dim3(grid_blocks), dim3(512), args, kLdsBytes, stream);
  if (e != hipSuccess) fprintf(stderr, "cooperative launch failed: %s (grid %d)\n", hipGetErrorString(e), grid_blocks);
}
```

```cpp
#include <hip/hip_runtime.h>
#include <hip/hip_cooperative_groups.h>
#include <cstdio>
#include <cstdint>
namespace cg = cooperative_groups;

#define LAS __attribute__((address_space(3)))
typedef unsigned short bf16_t;
typedef short bf16x8 __attribute__((ext_vector_type(8)));
typedef float f32x4 __attribute__((ext_vector_type(4)));
typedef float f32x2 __attribute__((ext_vector_type(2)));
typedef float f32x16 __attribute__((ext_vector_type(16)));
typedef unsigned u32x4 __attribute__((ext_vector_type(4)));
typedef unsigned u32x2 __attribute__((ext_vector_type(2)));

constexpr int kT = 32768, kD = 2048, kL = 2048, kB = 16, kINW = 5632;
constexpr int kLdsBytes = 144 * 1024;

constexpr int ZC_U = 0, ZC_SG = 512, ZC_AQ = 1024, ZC_AK = 2048, ZC_AV = 2304, ZC_AG = 2560, ZC_RQ = 3584, ZC_RK = 4096, ZC_RV = 4608, ZC_RG = 5120;

__device__ __forceinline__ unsigned f2bf(float f) { unsigned u = __builtin_bit_cast(unsigned, f); return (u + 0x7fffu + ((u >> 16) & 1u)) >> 16; }
__device__ __forceinline__ unsigned pk2(float lo, float hi) { unsigned r; asm("v_cvt_pk_bf16_f32 %0, %1, %2" : "=v"(r) : "v"(lo), "v"(hi)); return r; }
__device__ __forceinline__ float bflo(unsigned w) { return __builtin_bit_cast(float, w << 16); }
__device__ __forceinline__ float bfhi(unsigned w) { return __builtin_bit_cast(float, w & 0xffff0000u); }
__device__ __forceinline__ float bf2f(bf16_t h) { return __builtin_bit_cast(float, ((unsigned)h) << 16); }
__device__ __forceinline__ float silu_f(float v) { return v * __builtin_amdgcn_rcpf(1.0f + __expf(-v)); }
__device__ __forceinline__ float sigmoid_f(float v) { return __builtin_amdgcn_rcpf(1.0f + __expf(-v)); }
__device__ __forceinline__ float gelu_tanh_f(float v) {
  const float u = 0.7978845608028654f * (v + 0.044715f * v * v * v);
  const float e = __expf(2.0f * u);
  const float th = 1.0f - 2.0f * __builtin_amdgcn_rcpf(e + 1.0f);
  return 0.5f * v * (1.0f + th);
}
__device__ __forceinline__ float wave_sum(float v) {
#pragma unroll
  for (int o = 32; o >= 1; o >>= 1) v += __shfl_xor(v, o);
  return v;
}
__device__ __forceinline__ float wave_max(float v) {
#pragma unroll
  for (int o = 32; o >= 1; o >>= 1) v = fmaxf(v, __shfl_xor(v, o));
  return v;
}
__device__ __forceinline__ f32x16 mfma32(bf16x8 a, bf16x8 b, f32x16 c) { return __builtin_amdgcn_mfma_f32_32x32x16_bf16(a, b, c, 0, 0, 0); }
__device__ __forceinline__ f32x16 zero16() { f32x16 z;
#pragma unroll
  for (int i = 0; i < 16; ++i) z[i] = 0.f; return z; }
__device__ __forceinline__ bf16x8 ldg8(const bf16_t* p) { return *(const bf16x8*)p; }
__device__ __forceinline__ bf16x8 lds8(const LAS unsigned char* p) { return *(const LAS bf16x8*)p; }

__device__ __forceinline__ int opaque_tid() { int t = threadIdx.x; asm volatile("" : "+v"(t)); return t; }
typedef unsigned short u16x4 __attribute__((ext_vector_type(4)));
#define TR_READ8(R, BASE, O0, O1, O2, O3, O4, O5, O6, O7) \
  asm volatile("ds_read_b64_tr_b16 %0, %8 offset:" #O0 "\n\tds_read_b64_tr_b16 %1, %8 offset:" #O1 "\n\tds_read_b64_tr_b16 %2, %8 offset:" #O2 "\n\tds_read_b64_tr_b16 %3, %8 offset:" #O3 \
               "\n\tds_read_b64_tr_b16 %4, %8 offset:" #O4 "\n\tds_read_b64_tr_b16 %5, %8 offset:" #O5 "\n\tds_read_b64_tr_b16 %6, %8 offset:" #O6 "\n\tds_read_b64_tr_b16 %7, %8 offset:" #O7 \
               "\n\ts_waitcnt lgkmcnt(0)" \
               : "=&v"(R[0]), "=&v"(R[1]), "=&v"(R[2]), "=&v"(R[3]), "=&v"(R[4]), "=&v"(R[5]), "=&v"(R[6]), "=&v"(R[7]) : "v"(BASE) : "memory")
__device__ __forceinline__ bf16x8 tr_join(u16x4 lo, u16x4 hi) { bf16x8 r; r[0] = (short)lo[0]; r[1] = (short)lo[1]; r[2] = (short)lo[2]; r[3] = (short)lo[3]; r[4] = (short)hi[0]; r[5] = (short)hi[1]; r[6] = (short)hi[2]; r[7] = (short)hi[3]; return r; }
#define TR_READ16(R, BASE, O0, O1, O2, O3, O4, O5, O6, O7, O8, O9, O10, O11, O12, O13, O14, O15) \
  asm volatile("ds_read_b64_tr_b16 %0, %16 offset:" #O0 "\n\tds_read_b64_tr_b16 %1, %16 offset:" #O1 "\n\tds_read_b64_tr_b16 %2, %16 offset:" #O2 "\n\tds_read_b64_tr_b16 %3, %16 offset:" #O3 \
               "\n\tds_read_b64_tr_b16 %4, %16 offset:" #O4 "\n\tds_read_b64_tr_b16 %5, %16 offset:" #O5 "\n\tds_read_b64_tr_b16 %6, %16 offset:" #O6 "\n\tds_read_b64_tr_b16 %7, %16 offset:" #O7 \
               "\n\tds_read_b64_tr_b16 %8, %16 offset:" #O8 "\n\tds_read_b64_tr_b16 %9, %16 offset:" #O9 "\n\tds_read_b64_tr_b16 %10, %16 offset:" #O10 "\n\tds_read_b64_tr_b16 %11, %16 offset:" #O11 \
               "\n\tds_read_b64_tr_b16 %12, %16 offset:" #O12 "\n\tds_read_b64_tr_b16 %13, %16 offset:" #O13 "\n\tds_read_b64_tr_b16 %14, %16 offset:" #O14 "\n\tds_read_b64_tr_b16 %15, %16 offset:" #O15 \
               "\n\ts_waitcnt lgkmcnt(0)" \
               : "=&v"(R[0]), "=&v"(R[1]), "=&v"(R[2]), "=&v"(R[3]), "=&v"(R[4]), "=&v"(R[5]), "=&v"(R[6]), "=&v"(R[7]), "=&v"(R[8]), "=&v"(R[9]), "=&v"(R[10]), "=&v"(R[11]), "=&v"(R[12]), "=&v"(R[13]), "=&v"(R[14]), "=&v"(R[15]) : "v"(BASE) : "memory")

#define XB_TMO      128
#define XB_XCNT(j)  (256  + 64 * (j))
#define XB_XSUB(j)  (1280 + 64 * (j))
#define XB_XGEN(j)  (2304 + 64 * (j))
#define XB_TOP      3328
#define XB_TOPGEN   3392
#define XCD_BAR_WORDS 3456
#define XB_SPIN_CAP (1u << 18)

__device__ __forceinline__ unsigned xb_ld(unsigned* p)              { return __hip_atomic_load(p, __ATOMIC_RELAXED, __HIP_MEMORY_SCOPE_AGENT); }
__device__ __forceinline__ unsigned xb_add(unsigned* p, unsigned v) { return __hip_atomic_fetch_add(p, v, __ATOMIC_RELAXED, __HIP_MEMORY_SCOPE_AGENT); }
__device__ __forceinline__ unsigned xb_xcc_id() { return (unsigned)__builtin_amdgcn_s_getreg((3 << 11) | 20) & 0xFu; }

#define XB_SPIN(cond, bar) do { unsigned _sp = 0; while (cond) { __builtin_amdgcn_s_sleep(1); \
    if ((++_sp & 255u) == 0u) { if (xb_ld(&(bar)[XB_TMO])) break; if (_sp > XB_SPIN_CAP) { atomicAdd(&(bar)[XB_TMO], 1u); break; } } } } while (0)

struct XcdBarrier {
    unsigned* bar; unsigned x;
    volatile LAS unsigned* st;
};


__device__ __forceinline__ XcdBarrier xcd_barrier_post(unsigned* bar, volatile LAS unsigned* st) {
    XcdBarrier b; b.bar = bar; b.x = xb_xcc_id(); b.st = st;
    if (threadIdx.x == 0) (void)xb_add(&bar[XB_XCNT(b.x)], 1u);
    return b;
}


__device__ __forceinline__ void xcd_barrier_complete(unsigned* bar, unsigned x, unsigned& nloc, unsigned& nx) {
    const unsigned G = gridDim.x * gridDim.y * gridDim.z;
    unsigned sum, cnt, mine, sp = 0u;
    for (;;) {
        sum = 0u; cnt = 0u; mine = 0u;
#pragma unroll
        for (unsigned j = 0; j < 16; ++j) { const unsigned c = xb_ld(&bar[XB_XCNT(j)]); sum += c; cnt += (c > 0u) ? 1u : 0u; mine = (j == x) ? c : mine; }
        if (sum == G) break;
        __builtin_amdgcn_s_sleep(1);
        if ((++sp & 255u) == 0u) { if (xb_ld(&bar[XB_TMO])) break; if (sp > XB_SPIN_CAP) { atomicAdd(&bar[XB_TMO], 1u); break; } }
    }
    nloc = mine > 0u ? mine : 1u; nx = cnt > 0u ? cnt : 1u;
}


__device__ __forceinline__ void xcd_barrier(const XcdBarrier& b) {
    asm volatile("s_waitcnt vmcnt(0)" ::: "memory");
    __syncthreads();
    if (threadIdx.x == 0) {
        unsigned* bar = b.bar;
        __builtin_amdgcn_s_waitcnt(0);
        unsigned nloc = b.st[0], nx = b.st[1];
        if (nloc == 0u) { xcd_barrier_complete(bar, b.x, nloc, nx); b.st[0] = nloc; b.st[1] = nx; }
        const unsigned old = xb_add(&bar[XB_XSUB(b.x)], 1u);
        const unsigned gen = old / nloc;
        if (old + 1u == (gen + 1u) * nloc) {
            __builtin_amdgcn_fence(__ATOMIC_RELEASE, "agent");
            asm volatile("s_waitcnt vmcnt(0)" ::: "memory");


            const unsigned og = xb_add(&bar[XB_TOP], 1u);
            const unsigned tg = og / nx;
            if (og + 1u == (tg + 1u) * nx) xb_add(&bar[XB_TOPGEN], 1u);
            else XB_SPIN(xb_ld(&bar[XB_TOPGEN]) == tg, bar);
            __builtin_amdgcn_fence(__ATOMIC_ACQUIRE, "agent");
            xb_add(&bar[XB_XGEN(b.x)], 1u);
            asm volatile("s_waitcnt vmcnt(0)" ::: "memory");

        } else {
            XB_SPIN(xb_ld(&bar[XB_XGEN(b.x)]) == gen, bar);
            __builtin_amdgcn_fence(__ATOMIC_ACQUIRE, "agent");


            asm volatile("s_waitcnt vmcnt(0)" ::: "memory");
        }
    }
    __syncthreads();
}
namespace pg8 {
#define PG8_LAS __attribute__((address_space(3)))
typedef unsigned short bf16_t;
typedef short bf16x8 __attribute__((ext_vector_type(8)));
typedef float f32x4 __attribute__((ext_vector_type(4)));
typedef unsigned u32x4 __attribute__((ext_vector_type(4)));
constexpr int BM = 256, BK = 64, HALF = 128, HTB = HALF * BK * 2  , STAGE_BYTES = 8 * HTB, NXCD = 8, WGM = 8;


__host__ __device__ __forceinline__ int lds_byte(int r, int c) { const int st = (r >> 4) * 2 + (c >> 5), rr = r & 15, cc = c & 31, ob = rr * 64 + cc * 2; return st * 1024 + (ob ^ (((ob >> 9) & 1) << 5)); }
__host__ __device__ __forceinline__ void stage_rc(int b, int& R, int& C) { const int st = b / 1024, sb = b % 1024, swz = sb ^ (((sb >> 9) & 1) << 5); R = (st >> 1) * 16 + swz / 64; C = (st & 1) * 32 + (swz % 64) / 2; }
__host__ __device__ __forceinline__ int perm32(int rho) { const int n = rho >> 4, i = rho & 15; return 8 * (i >> 2) + 4 * n + (i & 3); }
struct Unit { int pm, pn; };
struct Gemm { const bf16_t* A; const bf16_t* Bt; int M, N, K; };
struct StaticOrder {
    int nM, nN, nwg, G, c;
    __host__ __device__ void init(int M, int N, int G_, int c_) { nM = M / BM; nN = N / BM; nwg = nM * nN; G = G_; c = c_; }
    __host__ __device__ bool next(int i, Unit& u) const {
        const long L = (long)i * G + c; if (L >= nwg) return false;
        int wgid = (int)L; { const int q = nwg / NXCD, r = nwg % NXCD, xcd = wgid % NXCD, off = wgid / NXCD; wgid = (xcd < r ? xcd * (q + 1) : r * (q + 1) + (xcd - r) * q) + off; }
        const int nig = WGM * nN, gid = wgid / nig, fm = gid * WGM, gsz = (nM - fm) < WGM ? (nM - fm) : WGM;
        u.pm = fm + ((wgid % nig) % gsz); u.pn = (wgid % nig) / gsz; return true;
    }
    __device__ __forceinline__ void a_ready(const Unit&) const {}
    __device__ __forceinline__ void done(const Unit&) const {}
};
__device__ __forceinline__ unsigned cvt_pk_bf16(float lo, float hi) { unsigned r; asm volatile("v_cvt_pk_bf16_f32 %0, %1, %2" : "=v"(r) : "v"(lo), "v"(hi)); return r; }
template <class Epi, class Sched, bool ALIGN_EPI = false, bool SP2 = false>
__device__ __forceinline__ void gemm_phase(PG8_LAS unsigned char* lds, const Gemm g, const Sched& S, const Epi& E) {
    const int tid = opaque_tid(), wid = __builtin_amdgcn_readfirstlane(tid >> 6), lane = tid & 63, wr = wid >> 2, wc = wid & 3, fr = lane & 15, fq = lane >> 4;
    const int K = g.K, nt = K / BK;

    unsigned voffA[2], voffB[2];
#pragma unroll
    for (int i = 0; i < 2; ++i) { int R, C; stage_rc(tid * 16 + i * 8192, R, C); const int Rb = Epi::PERM ? ((R & ~31) + perm32(R & 31)) : R;
        voffA[i] = (unsigned)(R * K + C) * 2u; voffB[i] = (unsigned)(Rb * K + C) * 2u; }
    const size_t kstep = (size_t)(BK * 2);
    const size_t hstep = (size_t)HALF * K * 2;
    const size_t tstep = 2 * hstep;
    const unsigned ldsw = (unsigned)wid * 1024u;

    const int aoff = lds_byte(wr * 64 + fr, fq * 8), boff = lds_byte(wc * 32 + fr, fq * 8);
#define PG8_SA(b, h) (((b) * 2 + (h)) * HTB)
#define PG8_SB(b, h) ((4 + (b) * 2 + (h)) * HTB)
#define PG8_STAGE(bufoff, gbase, voff) do { _Pragma("unroll") for (int _i = 0; _i < 2; ++_i) \
        __builtin_amdgcn_global_load_lds((const unsigned*)((const char*)(gbase) + (voff)[_i]), (PG8_LAS unsigned*)(lds + (bufoff) + ldsw + _i * 8192), 16, 0, 0); } while (0)
#define PG8_LDA(dst, b, h) do { _Pragma("unroll") for (int m = 0; m < 4; ++m) _Pragma("unroll") for (int k = 0; k < 2; ++k) dst[m][k] = *(const PG8_LAS bf16x8*)(lds + PG8_SA(b, h) + aoff + m * 2048 + k * 1024); } while (0)
#define PG8_LDB(dst, b, h) do { _Pragma("unroll") for (int n = 0; n < 2; ++n) _Pragma("unroll") for (int k = 0; k < 2; ++k) dst[n][k] = *(const PG8_LAS bf16x8*)(lds + PG8_SB(b, h) + boff + n * 2048 + k * 1024); } while (0)
#define PG8_MMA(ai, bj, At, Bt) do { __builtin_amdgcn_s_setprio(1); _Pragma("unroll") for (int m = 0; m < 4; ++m) _Pragma("unroll") for (int n = 0; n < 2; ++n) _Pragma("unroll") for (int k = 0; k < 2; ++k) \
        acc[ai][bj][m][n] = __builtin_amdgcn_mfma_f32_16x16x32_bf16(Bt[n][k], At[m][k], acc[ai][bj][m][n], 0, 0, 0); __builtin_amdgcn_s_setprio(0); } while (0)
#define PG8_WAIT_V(n) asm volatile("s_waitcnt vmcnt(" #n ")" ::: "memory")
#define PG8_WAIT_L(n) asm volatile("s_waitcnt lgkmcnt(" #n ")" ::: "memory")
#define PG8_BAR __builtin_amdgcn_s_barrier()
#define PG8_SCHED __builtin_amdgcn_sched_barrier(0)
    Unit cur, nxt; int ui = 0;
    if (!S.next(0, cur)) return;
    f32x4 acc[2][2][4][2];
#pragma unroll
    for (int a = 0; a < 2; ++a)
#pragma unroll
        for (int b = 0; b < 2; ++b)
#pragma unroll
            for (int m = 0; m < 4; ++m)
#pragma unroll
                for (int n = 0; n < 2; ++n) acc[a][b][m][n] = (f32x4){0.f, 0.f, 0.f, 0.f};
    bf16x8 At[4][2], B0[2][2], B1[2][2];

    const char* cA = (const char*)g.A + (size_t)cur.pm * tstep; const char* cB = (const char*)g.Bt + (size_t)cur.pn * tstep;
    S.a_ready(cur);

    if constexpr (SP2) {
        PG8_STAGE(PG8_SB(0, 0), cB, voffB); PG8_STAGE(PG8_SB(0, 1), cB + hstep, voffB); PG8_STAGE(PG8_SA(0, 0), cA, voffA); PG8_STAGE(PG8_SA(0, 1), cA + hstep, voffA);
        if (wr == 1) PG8_BAR;
        PG8_WAIT_V(2); PG8_BAR;
        PG8_STAGE(PG8_SB(1, 0), cB + kstep, voffB); PG8_STAGE(PG8_SA(1, 0), cA + kstep, voffA); PG8_STAGE(PG8_SB(1, 1), cB + hstep + kstep, voffB);
        PG8_WAIT_V(6); PG8_BAR;
    } else {
        PG8_STAGE(PG8_SB(0, 0), cB, voffB); PG8_STAGE(PG8_SA(0, 0), cA, voffA); PG8_STAGE(PG8_SB(0, 1), cB + hstep, voffB); PG8_STAGE(PG8_SA(0, 1), cA + hstep, voffA);
        if (wr == 1) PG8_BAR;
        PG8_WAIT_V(4); PG8_BAR;
        PG8_STAGE(PG8_SB(1, 0), cB + kstep, voffB); PG8_STAGE(PG8_SA(1, 0), cA + kstep, voffA); PG8_STAGE(PG8_SB(1, 1), cB + hstep + kstep, voffB);
        PG8_WAIT_V(6); PG8_BAR;
    }
    for (;;) {
        const bool has_next = S.next(ui + 1, nxt);

        const char* nA = has_next ? (const char*)g.A + (size_t)nxt.pm * tstep : cA; const char* nB = has_next ? (const char*)g.Bt + (size_t)nxt.pn * tstep : cB;
        for (int t = 0; t < nt; t += 2) {
            const bool last = (t == nt - 2);
            const char* a1 = cA + (size_t)(t + 1) * kstep;
            const char* a2 = last ? nA : cA + (size_t)(t + 2) * kstep; const char* b2 = last ? nB : cB + (size_t)(t + 2) * kstep;
            const char* a3 = a2 + kstep; const char* b3 = b2 + kstep;
            if (last && has_next) S.a_ready(nxt);
            if constexpr (SP2) {


            PG8_LDB(B0, 0, 0); PG8_LDB(B1, 0, 1); PG8_SCHED; PG8_LDA(At, 0, 0); PG8_STAGE(PG8_SA(1, 1), a1 + hstep, voffA);
            PG8_WAIT_V(8); PG8_WAIT_L(0); PG8_BAR; PG8_MMA(0, 0, At, B0); PG8_MMA(0, 1, At, B1); PG8_BAR; PG8_SCHED;

            PG8_LDA(At, 0, 1); PG8_STAGE(PG8_SB(0, 0), b2, voffB); PG8_STAGE(PG8_SB(0, 1), b2 + hstep, voffB); PG8_STAGE(PG8_SA(0, 0), a2, voffA);
            PG8_WAIT_V(8); PG8_WAIT_L(0); PG8_BAR; PG8_MMA(1, 0, At, B0); PG8_MMA(1, 1, At, B1); PG8_BAR; PG8_SCHED;

            PG8_LDB(B0, 1, 0); PG8_LDB(B1, 1, 1); PG8_SCHED; PG8_LDA(At, 1, 0); PG8_STAGE(PG8_SA(0, 1), a2 + hstep, voffA);
            PG8_WAIT_V(8); PG8_WAIT_L(0); PG8_BAR; PG8_MMA(0, 0, At, B0); PG8_MMA(0, 1, At, B1); PG8_BAR; PG8_SCHED;

            PG8_LDA(At, 1, 1); PG8_STAGE(PG8_SB(1, 0), b3, voffB); PG8_STAGE(PG8_SB(1, 1), b3 + hstep, voffB); PG8_STAGE(PG8_SA(1, 0), a3, voffA);
            PG8_WAIT_V(8); PG8_WAIT_L(0); PG8_BAR; PG8_MMA(1, 0, At, B0); PG8_MMA(1, 1, At, B1); PG8_BAR; PG8_SCHED;
            } else {

            PG8_LDB(B0, 0, 0); PG8_SCHED; PG8_LDA(At, 0, 0); PG8_STAGE(PG8_SA(1, 1), a1 + hstep, voffA);
            PG8_WAIT_L(8); PG8_BAR; PG8_WAIT_L(0); PG8_MMA(0, 0, At, B0); PG8_BAR; PG8_SCHED;

            PG8_LDB(B1, 0, 1); PG8_STAGE(PG8_SB(0, 0), b2, voffB);
            PG8_BAR; PG8_WAIT_L(0); PG8_MMA(0, 1, At, B1); PG8_BAR;

            PG8_LDA(At, 0, 1); PG8_STAGE(PG8_SA(0, 0), a2, voffA);
            PG8_BAR; PG8_WAIT_L(0); PG8_MMA(1, 0, At, B0); PG8_BAR; PG8_SCHED;

            PG8_STAGE(PG8_SB(0, 1), b2 + hstep, voffB);
            PG8_WAIT_V(6); PG8_BAR; PG8_MMA(1, 1, At, B1); PG8_BAR;

            PG8_LDB(B0, 1, 0); PG8_SCHED; PG8_LDA(At, 1, 0); PG8_STAGE(PG8_SA(0, 1), a2 + hstep, voffA);
            PG8_WAIT_L(8); PG8_BAR; PG8_WAIT_L(0); PG8_MMA(0, 0, At, B0); PG8_BAR; PG8_SCHED;

            PG8_LDB(B1, 1, 1); PG8_STAGE(PG8_SB(1, 0), b3, voffB);
            PG8_BAR; PG8_WAIT_L(0); PG8_MMA(0, 1, At, B1); PG8_BAR;

            PG8_LDA(At, 1, 1); PG8_STAGE(PG8_SA(1, 0), a3, voffA);
            PG8_BAR; PG8_WAIT_L(0); PG8_MMA(1, 0, At, B0); PG8_BAR; PG8_SCHED;

            PG8_STAGE(PG8_SB(1, 1), b3 + hstep, voffB);
            PG8_WAIT_V(6); PG8_BAR; PG8_MMA(1, 1, At, B1); PG8_BAR;
            }
        }
        if constexpr (ALIGN_EPI) { if (wr == 0) PG8_BAR; }
        if constexpr (!Epi::AFTER_DRAIN) { E(acc, cur, wr, wc, fr, fq); S.done(cur); }
        if (!has_next) break;
#pragma unroll
        for (int a = 0; a < 2; ++a)
#pragma unroll
            for (int b = 0; b < 2; ++b)
#pragma unroll
                for (int m = 0; m < 4; ++m)
#pragma unroll
                    for (int n = 0; n < 2; ++n) acc[a][b][m][n] = (f32x4){0.f, 0.f, 0.f, 0.f};
        cur = nxt; cA = nA; cB = nB; ++ui;
        if constexpr (ALIGN_EPI) { if (wr == 1) PG8_BAR; }
    }
    PG8_WAIT_V(0);
    if constexpr (!ALIGN_EPI) { if (wr == 0) PG8_BAR; }
    PG8_BAR;
    if constexpr (Epi::AFTER_DRAIN) { E.fused(acc, cur, wr, wc, fr, fq, lds, wid, lane); S.done(cur); }
#undef PG8_SA
#undef PG8_SB
#undef PG8_STAGE
#undef PG8_LDA
#undef PG8_LDB
#undef PG8_MMA
#undef PG8_WAIT_V
#undef PG8_WAIT_L
#undef PG8_BAR
#undef PG8_SCHED
}
}

constexpr size_t WS_WIN = 0;
constexpr size_t WS_WOUT = WS_WIN + (size_t)2 * 5632 * 2048 * 2;
constexpr size_t WS_GLU = WS_WOUT + (size_t)2 * 2048 * 2048 * 2;
constexpr size_t WS_ADA = WS_GLU + (size_t)2 * 512 * 512 * 2;
constexpr size_t WS_EE = WS_ADA + (size_t)2 * 16 * 6144 * 4;
constexpr size_t WS_MF = WS_EE + (size_t)2 * 32 * 256 * 256 * 2;
constexpr size_t WS_A16 = WS_MF + (size_t)2 * 32 * 256 * 512 * 2;
constexpr size_t WS_H = WS_A16 + (size_t)2 * 32 * 2 * 64 * 2 * 4;
constexpr size_t WS_Z = WS_H + (size_t)kT * 2048 * 2;
constexpr size_t WS_AVT = WS_Z + (size_t)kT * kINW * 2;
constexpr size_t WS_RKF = WS_AVT + (size_t)16 * 2 * 128 * 2048 * 2;
constexpr size_t WS_RKB = WS_RKF + (size_t)16 * 4 * 128 * 2048 * 2;
constexpr size_t WS_RVT = WS_RKB + (size_t)16 * 4 * 128 * 2048 * 2;
constexpr size_t WS_UB = WS_RVT + (size_t)16 * 4 * 128 * 2048 * 2;
constexpr size_t WS_YS = WS_UB + (size_t)kT * 512 * 2;
constexpr size_t WS_KVF = WS_YS + (size_t)kT * 512 * 2;
constexpr size_t WS_KVB = WS_KVF + (size_t)16 * 4 * 16 * 16384 * 4;
constexpr size_t WS_SP = WS_KVB + (size_t)16 * 4 * 16 * 16384 * 4;
constexpr size_t WS_SF = WS_SP + (size_t)16 * 4 * 16 * 16384 * 2;
constexpr size_t WS_RA = WS_SF + (size_t)16 * 4 * 16 * 16384 * 2;
constexpr size_t WS_RR = WS_RA + (size_t)kT * 16 * 8;
constexpr size_t WS_CTL = WS_RR + (size_t)kT * 64 * 8;
constexpr size_t CTL_BYTES = 16384;
constexpr size_t WS_END = WS_CTL + CTL_BYTES;
static_assert(WS_END <= (size_t)1073741824, "workspace fits 1 GiB");

struct Params { const float* in[22]; float* out; unsigned char* ws; };

struct EpiZ {
  static constexpr bool PERM = true, AFTER_DRAIN = false;
  bf16_t* Z;
  __device__ __forceinline__ void operator()(const f32x4 (&acc)[2][2][4][2], const pg8::Unit& u, int wr, int wc, int fr, int fq) const {
    const int pn = u.pn;
    const bool gate = (pn == 2 || pn == 3 || (pn >= 10 && pn <= 13) || pn >= 20);
    const int row0 = u.pm * 256 + wr * 64 + fr, col0 = pn * 256 + wc * 32 + 8 * fq;
#pragma unroll
    for (int ai = 0; ai < 2; ++ai)
#pragma unroll
      for (int m = 0; m < 4; ++m) {
        bf16_t* rowp = Z + (size_t)(row0 + ai * 128 + m * 16) * kINW + col0;
#pragma unroll
        for (int bj = 0; bj < 2; ++bj) {
          f32x4 v0 = acc[ai][bj][m][0], v1 = acc[ai][bj][m][1];
          if (gate) {
#pragma unroll
            for (int j = 0; j < 4; ++j) { v0[j] = silu_f(v0[j]); v1[j] = silu_f(v1[j]); }
          }
          u32x4 w; w.x = pk2(v0[0], v0[1]); w.y = pk2(v0[2], v0[3]); w.z = pk2(v1[0], v1[1]); w.w = pk2(v1[2], v1[3]);
          *(u32x4*)(rowp + bj * 128) = w;
        }
      }
  }
};
struct EpiGlu {
  static constexpr bool PERM = true, AFTER_DRAIN = false;
  const bf16_t* YS; const bf16_t* Z; const float* bias; bf16_t* YC;
  __device__ __forceinline__ void operator()(const f32x4 (&acc)[2][2][4][2], const pg8::Unit& u, int wr, int wc, int fr, int fq) const {
    const int row0 = u.pm * 256 + wr * 64 + fr, col0 = u.pn * 256 + wc * 32 + 8 * fq;
    f32x4 bv[2][2];
#pragma unroll
    for (int bj = 0; bj < 2; ++bj) { bv[bj][0] = *(const f32x4*)(bias + col0 + bj * 128); bv[bj][1] = *(const f32x4*)(bias + col0 + bj * 128 + 4); }
#pragma unroll
    for (int ai = 0; ai < 2; ++ai)
#pragma unroll
      for (int mp = 0; mp < 2; ++mp) {
        u32x4 yv[2][2], gv[2][2];
#pragma unroll
        for (int mm = 0; mm < 2; ++mm)
#pragma unroll
          for (int bj = 0; bj < 2; ++bj) {
            const size_t row = (size_t)(row0 + ai * 128 + (mp * 2 + mm) * 16); const int col = col0 + bj * 128;
            yv[mm][bj] = *(const u32x4*)(YS + row * 512 + col); gv[mm][bj] = *(const u32x4*)(Z + row * kINW + ZC_SG + col);
          }
#pragma unroll
        for (int mm = 0; mm < 2; ++mm)
#pragma unroll
          for (int bj = 0; bj < 2; ++bj) {
            const int m = mp * 2 + mm;
            const size_t row = (size_t)(row0 + ai * 128 + m * 16); const int col = col0 + bj * 128;
            const f32x4 a0 = acc[ai][bj][m][0] + bv[bj][0], a1 = acc[ai][bj][m][1] + bv[bj][1];
            const u32x4 y4 = yv[mm][bj], g4 = gv[mm][bj];
            u32x4 w;
            w.x = pk2(bflo(y4.x) * sigmoid_f(a0[0]) * bflo(g4.x), bfhi(y4.x) * sigmoid_f(a0[1]) * bfhi(g4.x));
            w.y = pk2(bflo(y4.y) * sigmoid_f(a0[2]) * bflo(g4.y), bfhi(y4.y) * sigmoid_f(a0[3]) * bfhi(g4.y));
            w.z = pk2(bflo(y4.z) * sigmoid_f(a1[0]) * bflo(g4.z), bfhi(y4.z) * sigmoid_f(a1[1]) * bfhi(g4.z));
            w.w = pk2(bflo(y4.w) * sigmoid_f(a1[2]) * bflo(g4.w), bfhi(y4.w) * sigmoid_f(a1[3]) * bfhi(g4.w));
            *(u32x4*)(YC + row * 2048 + col) = w;
          }
      }
  }
};
struct EpiOut {
  static constexpr bool PERM = false, AFTER_DRAIN = false;
  const float* Xin; float* Xout; const float* gate;
  __device__ __forceinline__ void operator()(const f32x4 (&acc)[2][2][4][2], const pg8::Unit& u, int wr, int wc, int fr, int fq) const {
    const int row0 = u.pm * 256 + wr * 64 + fr, col0 = u.pn * 256 + wc * 32 + 4 * fq;
    const float* gp = gate + (size_t)(u.pm >> 3) * 6144 + col0;
    f32x4 gv[2][2];
#pragma unroll
    for (int bj = 0; bj < 2; ++bj)
#pragma unroll
      for (int n = 0; n < 2; ++n) gv[bj][n] = *(const f32x4*)(gp + bj * 128 + n * 16);
#pragma unroll
    for (int ai = 0; ai < 2; ++ai)
#pragma unroll
      for (int mp = 0; mp < 2; ++mp) {
        f32x4 xv[2][2][2];
#pragma unroll
        for (int mm = 0; mm < 2; ++mm)
#pragma unroll
          for (int bj = 0; bj < 2; ++bj)
#pragma unroll
            for (int n = 0; n < 2; ++n) xv[mm][bj][n] = *(const f32x4*)(Xin + (size_t)(row0 + ai * 128 + (mp * 2 + mm) * 16) * 2048 + col0 + bj * 128 + n * 16);
#pragma unroll
        for (int mm = 0; mm < 2; ++mm)
#pragma unroll
          for (int bj = 0; bj < 2; ++bj)
#pragma unroll
            for (int n = 0; n < 2; ++n)
              *(f32x4*)(Xout + (size_t)(row0 + ai * 128 + (mp * 2 + mm) * 16) * 2048 + col0 + bj * 128 + n * 16) = xv[mm][bj][n] + gv[bj][n] * acc[ai][bj][mp * 2 + mm][n];
      }
  }
};

__device__ __forceinline__ float lgam2(int h) { return log1pf(-exp2f(-5.0f - (float)h)) * 1.4426950408889634f; }

struct TrUnit { const float* src; bf16_t* dst; int N, K; };
__device__ __forceinline__ TrUnit tr_decode(const Params& p, int u) {
  const int l = u / 3904, r = u % 3904; TrUnit t;
  if (r < 2816) { const int tk = r / 88, tn = r % 88; t.N = 5632; t.K = 2048; t.src = p.in[6] + (size_t)l * 2048 * 5632 + (size_t)tk * 64 * 5632 + tn * 64; t.dst = (bf16_t*)(p.ws + WS_WIN) + (size_t)l * 5632 * 2048 + (size_t)tn * 64 * 2048 + tk * 64; }
  else if (r < 3840) { const int q = r - 2816, tk = q >> 5, tn = q & 31; t.N = 2048; t.K = 2048; t.src = p.in[7] + (size_t)l * 2048 * 2048 + (size_t)tk * 64 * 2048 + tn * 64; t.dst = (bf16_t*)(p.ws + WS_WOUT) + (size_t)l * 2048 * 2048 + (size_t)tn * 64 * 2048 + tk * 64; }
  else { const int q = r - 3840, tk = q >> 3, tn = q & 7; t.N = 512; t.K = 512; t.src = p.in[16] + (size_t)l * 512 * 512 + (size_t)tk * 64 * 512 + tn * 64; t.dst = (bf16_t*)(p.ws + WS_GLU) + (size_t)l * 512 * 512 + (size_t)tn * 64 * 512 + tk * 64; }
  return t;
}
__device__ __forceinline__ void tr_load(const Params& p, int u, int tid, f32x4 (&v)[2]) {
  if (u < 7808) { const TrUnit t = tr_decode(p, u);
#pragma unroll
    for (int i = 0; i < 2; ++i) { const int idx = tid + i * 512, r = idx >> 4, c4 = idx & 15; v[i] = *(const f32x4*)(t.src + (size_t)r * t.N + c4 * 4); } }
}
__device__ __forceinline__ void tr_store(const Params& p, int u, int tid, const f32x4 (&v)[2], LAS float* scr) {
  if (u < 7808) {
    const TrUnit t = tr_decode(p, u);
    __syncthreads();
#pragma unroll
    for (int i = 0; i < 2; ++i) { const int idx = tid + i * 512, r = idx >> 4, c4 = idx & 15; LAS float* d = scr + r * 65 + c4 * 4; d[0] = v[i][0]; d[1] = v[i][1]; d[2] = v[i][2]; d[3] = v[i][3]; }
    __syncthreads();
    const int n = tid >> 3, kc = tid & 7;
    float f[8];
#pragma unroll
    for (int j = 0; j < 8; ++j) f[j] = scr[(kc * 8 + j) * 65 + n];
    u32x4 w; w.x = pk2(f[0], f[1]); w.y = pk2(f[2], f[3]); w.z = pk2(f[4], f[5]); w.w = pk2(f[6], f[7]);
    *(u32x4*)(t.dst + (size_t)n * t.K + kc * 8) = w;
  }
}

__device__ __forceinline__ void ada_unit(const Params& p, int u, LAS unsigned char* lds, int tid) {
  const int l = u / 96, cgp = u % 96, lane = tid & 63, wave = tid >> 6;
  const int kq = lane >> 4, c4 = lane & 15;
  LAS float* cact = (LAS float*)lds;
  const float* c = p.in[1];
  __syncthreads();
  for (int i = tid; i < 8192; i += 512) {
    const int k = i & 2047, bq = i >> 11;
    f32x4 v; v[0] = silu_f(c[(4 * bq) * 2048 + k]); v[1] = silu_f(c[(4 * bq + 1) * 2048 + k]); v[2] = silu_f(c[(4 * bq + 2) * 2048 + k]); v[3] = silu_f(c[(4 * bq + 3) * 2048 + k]);
    *(LAS f32x4*)(cact + k * 16 + 4 * bq) = v;
  }
  __syncthreads();
  const float* W = p.in[4] + (size_t)l * 2048 * 6144 + cgp * 64 + 4 * c4;
  f32x4 acc[16];
#pragma unroll
  for (int b = 0; b < 16; ++b) acc[b] = (f32x4){0.f, 0.f, 0.f, 0.f};
  for (int i0 = 0; i0 < 64; i0 += 16) {
    f32x4 wv[16];
#pragma unroll
    for (int ii = 0; ii < 16; ++ii) wv[ii] = *(const f32x4*)(W + (size_t)(wave * 256 + 4 * (i0 + ii) + kq) * 6144);
#pragma unroll
    for (int ii = 0; ii < 16; ++ii) {
      const int k = wave * 256 + 4 * (i0 + ii) + kq;
      const f32x4 c0 = *(LAS f32x4*)(cact + k * 16), c1 = *(LAS f32x4*)(cact + k * 16 + 4), c2 = *(LAS f32x4*)(cact + k * 16 + 8), c3 = *(LAS f32x4*)(cact + k * 16 + 12);
#pragma unroll
      for (int j = 0; j < 4; ++j) { acc[j] += wv[ii] * c0[j]; acc[4 + j] += wv[ii] * c1[j]; acc[8 + j] += wv[ii] * c2[j]; acc[12 + j] += wv[ii] * c3[j]; }
    }
  }
#pragma unroll
  for (int b = 0; b < 16; ++b)
#pragma unroll
    for (int j = 0; j < 4; ++j) { float v = acc[b][j]; v += __shfl_xor(v, 16); v += __shfl_xor(v, 32); acc[b][j] = v; }
  __syncthreads();
  LAS float* red = (LAS float*)lds;
  if (kq == 0) {
#pragma unroll
    for (int b = 0; b < 16; ++b) *(LAS f32x4*)(red + (wave * 16 + b) * 64 + 4 * c4) = acc[b];
  }
  __syncthreads();
  float* ada = (float*)(p.ws + WS_ADA);
#pragma unroll
  for (int i = 0; i < 2; ++i) {
    const int o = tid + i * 512, b = o >> 6, nn = o & 63;
    float s = 0.f;
#pragma unroll
    for (int w = 0; w < 8; ++w) s += red[(w * 16 + b) * 64 + nn];
    ada[(size_t)(l * 16 + b) * 6144 + cgp * 64 + nn] = s + p.in[5][l * 6144 + cgp * 64 + nn];
  }
  __syncthreads();
}

__device__ __forceinline__ void s5mat_unit(const Params& p, int u, LAS unsigned char* lds, int tid) {
  const int l = u >> 5, g = u & 31;
  LAS float* pwre = (LAS float*)lds;
  LAS float* pwim = pwre + 2176;
  LAS float* bbre = pwim + 2176;
  LAS float* bbim = bbre + 2048;
  LAS float* cre = bbim + 2048;
  LAS float* cim = cre + 2048;
  LAS float* Kf = cim + 2048;
  LAS float* Kb = Kf + 4096;
  __syncthreads();
  if (tid < 128) {
    const int dir = tid >> 6, n = tid & 63;
    const int ig = (l * 2 + dir) * 32 + g;
    const float dt = expf(p.in[10][ig]);
    const float lr = p.in[8][ig * 64 + n], li = p.in[9][ig * 64 + n];
    for (int k = 0; k <= 16; ++k) {
      const float mag = expf(lr * dt * (float)k); float s, c; sincosf(li * dt * (float)k, &s, &c);
      pwre[(dir * 17 + k) * 64 + n] = mag * c; pwim[(dir * 17 + k) * 64 + n] = mag * s;
    }
    const float mag = expf(lr * dt); float s1, c1; sincosf(li * dt, &s1, &c1);
    const float abr = mag * c1, abi = mag * s1, nr = abr - 1.0f, den = lr * lr + li * li;
    const float fre = (nr * lr + abi * li) / den, fim = (abi * lr - nr * li) / den;
    for (int q = 0; q < 16; ++q) {
      const float br = p.in[11][((size_t)ig * 64 + n) * 16 + q], bi = p.in[12][((size_t)ig * 64 + n) * 16 + q];
      bbre[(dir * 64 + n) * 16 + q] = fre * br - fim * bi; bbim[(dir * 64 + n) * 16 + q] = fre * bi + fim * br;
    }
    float* a16 = (float*)(p.ws + WS_A16) + ((size_t)((l * 32 + g) * 2 + dir) * 64 + n) * 2;
    const float m16 = expf(lr * dt * 16.0f); float s16, c16; sincosf(li * dt * 16.0f, &s16, &c16);
    a16[0] = m16 * c16; a16[1] = m16 * s16;
  }
  for (int i = tid; i < 2048; i += 512) {
    const int dir = i >> 10, r = i & 1023;
    const size_t gi = ((size_t)((l * 2 + dir) * 32 + g)) * 1024 + r;
    cre[i] = p.in[13][gi]; cim[i] = p.in[14][gi];
  }
  __syncthreads();
  {
    const int dir = tid >> 8, tau = (tid >> 4) & 15, pp = tid & 15;
    float sq[16];
#pragma unroll
    for (int q = 0; q < 16; ++q) sq[q] = 0.f;
    for (int n = 0; n < 64; ++n) {
      const float cr = cre[(dir * 16 + pp) * 64 + n], ci = cim[(dir * 16 + pp) * 64 + n];
      const float pr = pwre[(dir * 17 + tau) * 64 + n], pi = pwim[(dir * 17 + tau) * 64 + n];
      const float xr = cr * pr - ci * pi, xi = cr * pi + ci * pr;
      const LAS f32x4* br4 = (const LAS f32x4*)(bbre + (dir * 64 + n) * 16);
      const LAS f32x4* bi4 = (const LAS f32x4*)(bbim + (dir * 64 + n) * 16);
#pragma unroll
      for (int q4 = 0; q4 < 4; ++q4) { const f32x4 br = br4[q4], bi = bi4[q4];
#pragma unroll
        for (int j = 0; j < 4; ++j) sq[q4 * 4 + j] += xr * br[j] - xi * bi[j]; }
    }
#pragma unroll
    for (int q = 0; q < 16; ++q) (dir ? Kb : Kf)[tau * 256 + pp * 16 + q] = sq[q];
  }
  __syncthreads();
  bf16_t* EE = (bf16_t*)(p.ws + WS_EE) + (size_t)(l * 32 + g) * 256 * 256;
  for (int ch = tid; ch < 8192; ch += 512) {
    const int row = ch >> 5, c8 = (ch & 31) * 8, j = c8 >> 4, q0 = c8 & 15;
    const int dir = row >> 7, part = (row >> 6) & 1, n = row & 63;
    const int kp = dir ? j : 15 - j;
    const float pr = pwre[(dir * 17 + kp) * 64 + n], pi = pwim[(dir * 17 + kp) * 64 + n];
    float f[8];
#pragma unroll
    for (int e = 0; e < 8; ++e) {
      const float br = bbre[(dir * 64 + n) * 16 + q0 + e], bi = bbim[(dir * 64 + n) * 16 + q0 + e];
      f[e] = part ? (pr * bi + pi * br) : (pr * br - pi * bi);
    }
    u32x4 w; w.x = pk2(f[0], f[1]); w.y = pk2(f[2], f[3]); w.z = pk2(f[4], f[5]); w.w = pk2(f[6], f[7]);
    *(u32x4*)(EE + (size_t)row * 256 + c8) = w;
  }
  bf16_t* MF = (bf16_t*)(p.ws + WS_MF) + (size_t)(l * 32 + g) * 256 * 512;
  for (int ch = tid; ch < 16384; ch += 512) {
    const int row = ch >> 6, c8 = (ch & 63) * 8, i = row >> 4, pp = row & 15;
    float f[8];
    if (c8 < 256) {
      const int j = c8 >> 4, q0 = c8 & 15;
#pragma unroll
      for (int e = 0; e < 8; ++e) {
        const int q = q0 + e; float v = 0.f;
        if (i >= j) v += Kf[(i - j) * 256 + pp * 16 + q];
        if (j >= i) v += Kb[(j - i) * 256 + pp * 16 + q];
        if (i == j && pp == q) v += p.in[15][l * 512 + g * 16 + pp];
        f[e] = v;
      }
    } else {
#pragma unroll
      for (int e = 0; e < 8; ++e) {
        const int cc = c8 - 256 + e, dir = cc >> 7, part = (cc >> 6) & 1, n = cc & 63;
        const int kp = dir ? 16 - i : i + 1;
        const float cr = cre[(dir * 16 + pp) * 64 + n], ci = cim[(dir * 16 + pp) * 64 + n];
        const float pr = pwre[(dir * 17 + kp) * 64 + n], pi = pwim[(dir * 17 + kp) * 64 + n];
        f[e] = part ? -(cr * pi + ci * pr) : (cr * pr - ci * pi);
      }
    }
    u32x4 w; w.x = pk2(f[0], f[1]); w.y = pk2(f[2], f[3]); w.z = pk2(f[4], f[5]); w.w = pk2(f[6], f[7]);
    *(u32x4*)(MF + (size_t)row * 512 + c8) = w;
  }
  __syncthreads();
}

__device__ __forceinline__ void phase0(const Params& p, LAS unsigned char* lds, int tid, int G) {
  for (int su = blockIdx.x; su < 256; su += G) { if (su < 192) ada_unit(p, su, lds, tid); else s5mat_unit(p, su - 192, lds, tid); }
  {
    float* ropeA = (float*)(p.ws + WS_RA); float* ropeR = (float*)(p.ws + WS_RR);
    const int* pos = (const int*)p.in[2];
  }
  LAS float* scr = (LAS float*)lds;
  {
    f32x4 tb[4][2];
    const bool split = (G == 256);
    const int bx = blockIdx.x, nmine = split ? (bx < 192 ? 33 : 23) : (7808 - bx + G - 1) / G;
#define TR_UNIT(J) ((J) < nmine ? (split ? (bx < 192 ? (J) * 192 + bx : 6336 + (J) * 64 + (bx - 192)) : bx + (J) * G) : 7808)
    tr_load(p, TR_UNIT(0), tid, tb[0]); tr_load(p, TR_UNIT(1), tid, tb[1]); tr_load(p, TR_UNIT(2), tid, tb[2]);
    for (int jb = 0; jb < nmine; jb += 4) {
#pragma unroll
      for (int j = 0; j < 4; ++j) {
        tr_load(p, TR_UNIT(jb + j + 3), tid, tb[(j + 3) & 3]);
        tr_store(p, TR_UNIT(jb + j), tid, tb[j], scr);
      }
    }
#undef TR_UNIT
  }
}

__device__ __forceinline__ void norm_phase(const Params& p, int l, const float* xin, int tid, int G) {
  const int lane = tid & 63, wave = tid >> 6;
  bf16_t* H = (bf16_t*)(p.ws + WS_H);
  const float* ada = (const float*)(p.ws + WS_ADA) + (size_t)l * 16 * 6144;
  const float* nw = p.in[3] + l * 2048;
  const int stride = G * 8;
  const int* pos = (const int*)p.in[2];
  float* ropeA = (float*)(p.ws + WS_RA); float* ropeR = (float*)(p.ws + WS_RR);
  const float invr = powf(10000.0f, -(float)lane * (2.0f / 128.0f)), inva = powf(500000.0f, -(float)(lane & 15) * (2.0f / 32.0f));
  int row = blockIdx.x * 8 + wave;
  f32x4 v[8], vn[8];
  if (row < kT) {
#pragma unroll
    for (int i = 0; i < 8; ++i) v[i] = __builtin_nontemporal_load((const f32x4*)(xin + (size_t)row * 2048 + (i * 64 + lane) * 4));
  }
  for (; row < kT; row += stride) {
    const int nrow = row + stride;
    if (nrow < kT) {
#pragma unroll
      for (int i = 0; i < 8; ++i) vn[i] = __builtin_nontemporal_load((const f32x4*)(xin + (size_t)nrow * 2048 + (i * 64 + lane) * 4));
    }
    if (l == 0) {
      const float fpos = (float)pos[row];
      float sv, cv; sincosf(fpos * invr, &sv, &cv);
      f32x2 o; o.x = cv; o.y = sv; *(f32x2*)(ropeR + ((size_t)row * 64 + lane) * 2) = o;
      float sa, ca; sincosf(fpos * inva, &sa, &ca);
      if (lane < 16) { f32x2 oa; oa.x = ca; oa.y = sa; *(f32x2*)(ropeA + ((size_t)row * 16 + lane) * 2) = oa; }
    }
    const int b = row >> 11;
    float ss = 0.f;
#pragma unroll
    for (int i = 0; i < 8; ++i) ss += v[i][0] * v[i][0] + v[i][1] * v[i][1] + v[i][2] * v[i][2] + v[i][3] * v[i][3];
    ss = wave_sum(ss);
    const float rstd = rsqrtf(ss * (1.0f / 2048.0f) + 1e-6f);
    u32x2 ow[8];
#pragma unroll
    for (int i = 0; i < 8; ++i) {
      const int col = (i * 64 + lane) * 4;
      const f32x4 w4 = *(const f32x4*)(nw + col), sh = *(const f32x4*)(ada + (size_t)b * 6144 + col), sc = *(const f32x4*)(ada + (size_t)b * 6144 + 2048 + col);
      const f32x4 y = v[i] * rstd * w4 * (sc + 1.0f) + sh;
      ow[i].x = pk2(y[0], y[1]); ow[i].y = pk2(y[2], y[3]);
    }
#pragma unroll
    for (int i = 0; i < 8; ++i) *(u32x2*)(H + (size_t)row * 2048 + (i * 64 + lane) * 4) = ow[i];
#pragma unroll
    for (int i = 0; i < 8; ++i) v[i] = vn[i];
  }
}

__device__ __forceinline__ void unpack8(const u32x4 v, float (&f)[8]) { f[0] = bflo(v.x); f[1] = bfhi(v.x); f[2] = bflo(v.y); f[3] = bfhi(v.y); f[4] = bflo(v.z); f[5] = bfhi(v.z); f[6] = bflo(v.w); f[7] = bfhi(v.w); }
__device__ __forceinline__ u32x4 pack8(const float (&f)[8]) { u32x4 w; w.x = pk2(f[0], f[1]); w.y = pk2(f[2], f[3]); w.z = pk2(f[4], f[5]); w.w = pk2(f[6], f[7]); return w; }
__device__ __forceinline__ void prep_phase(const Params& p, int l, LAS unsigned char* lds, int tid, int G) {
  bf16_t* Z = (bf16_t*)(p.ws + WS_Z);
  bf16_t* AVT = (bf16_t*)(p.ws + WS_AVT);
  bf16_t* RKF = (bf16_t*)(p.ws + WS_RKF);
  bf16_t* RKB = (bf16_t*)(p.ws + WS_RKB);
  bf16_t* RVT = (bf16_t*)(p.ws + WS_RVT);
  const float* ropeA = (const float*)(p.ws + WS_RA);
  const float* ropeR = (const float*)(p.ws + WS_RR);
  const float* qn = p.in[18] + l * 128; const float* kn = p.in[19] + l * 128;
  const int c = tid & 15, rsub = tid >> 4;
  const float qs = 0.08838834764831845f;
  LAS bf16_t* tile = (LAS bf16_t*)lds;
  for (int unit = blockIdx.x; unit < 512; unit += G) {
    const int tok0 = unit * 64, b = tok0 >> 11;
    for (int kind = 1; kind < 2; ++kind) {
      float wn[8], wqf[8];
      { const f32x4 a = *(const f32x4*)(qn + 8 * c), bq = *(const f32x4*)(qn + 8 * c + 4);
        wqf[0] = a[0]; wqf[1] = a[1]; wqf[2] = a[2]; wqf[3] = a[3]; wqf[4] = bq[0]; wqf[5] = bq[1]; wqf[6] = bq[2]; wqf[7] = bq[3]; }
      { const f32x4 a = *(const f32x4*)((kind ? kn : qn) + 8 * c), bq = *(const f32x4*)((kind ? kn : qn) + 8 * c + 4);
        wn[0] = a[0]; wn[1] = a[1]; wn[2] = a[2]; wn[3] = a[3]; wn[4] = bq[0]; wn[5] = bq[1]; wn[6] = bq[2]; wn[7] = bq[3]; }
      const int nit = kind ? 4 : 16;
      for (int it0 = 0; it0 < nit; it0 += 4) {
        u32x4 vv[4]; f32x4 rr[4][4];
#pragma unroll
        for (int q = 0; q < 4; ++q) {
          const int R = (it0 + q) * 32 + rsub, hh = R >> 6, ts = R & 63, tok = tok0 + ts;
          vv[q] = *(const u32x4*)(Z + (size_t)tok * kINW + (kind ? ZC_AK : ZC_AQ) + hh * 128 + 8 * c);
          const float* rp = ropeA + ((size_t)tok * 16 + 8 * (c & 1)) * 2;
          rr[q][0] = *(const f32x4*)rp; rr[q][1] = *(const f32x4*)(rp + 4); rr[q][2] = *(const f32x4*)(rp + 8); rr[q][3] = *(const f32x4*)(rp + 12);
        }
#pragma unroll
        for (int q = 0; q < 4; ++q) {
          const int R = (it0 + q) * 32 + rsub, hh = R >> 6, ts = R & 63, tok = tok0 + ts;
          float f[8]; unpack8(vv[q], f);
          float ss = 0.f;
#pragma unroll
          for (int j = 0; j < 8; ++j) ss += f[j] * f[j];
          ss += __shfl_xor(ss, 1); ss += __shfl_xor(ss, 2); ss += __shfl_xor(ss, 4); ss += __shfl_xor(ss, 8);
          const float rstd = rsqrtf(ss * (1.0f / 128.0f) + 1e-6f);
          const f32x4 r0 = rr[q][0], r1 = rr[q][1], r2 = rr[q][2], r3 = rr[q][3];
          const float cs[8] = {r0[0], r0[2], r1[0], r1[2], r2[0], r2[2], r3[0], r3[2]};
          const float sn[8] = {r0[1], r0[3], r1[1], r1[3], r2[1], r2[3], r3[1], r3[3]};
          const float sgn = (c & 2) ? 1.0f : -1.0f;
#pragma unroll
          for (int j = 0; j < 8; ++j) {
            const float y = f[j] * rstd * wn[j];
            const float pr = __shfl_xor(y, 2);
            f[j] = (c < 4) ? (y * cs[j] + sgn * pr * sn[j]) : y * wqf[j];
          }
          *(u32x4*)(Z + (size_t)tok * kINW + (kind ? ZC_AK : ZC_AQ) + hh * 128 + 8 * c) = pack8(f);
        }
      }
    }
    for (int it0 = 0; it0 < 16; it0 += 4) {
      u32x4 vv[4]; f32x4 rr[4][4];
#pragma unroll
      for (int q = 0; q < 4; ++q) {
        const int R = (it0 + q) * 32 + rsub, hh = R >> 6, ts = R & 63, tok = tok0 + ts;
        vv[q] = *(const u32x4*)(Z + (size_t)tok * kINW + (hh < 4 ? ZC_RQ + hh * 128 : ZC_RK + (hh - 4) * 128) + 8 * c);
        const float* rp = ropeR + ((size_t)tok * 64 + 8 * (c & 7)) * 2;
        rr[q][0] = *(const f32x4*)rp; rr[q][1] = *(const f32x4*)(rp + 4); rr[q][2] = *(const f32x4*)(rp + 8); rr[q][3] = *(const f32x4*)(rp + 12);
      }
#pragma unroll
      for (int q = 0; q < 4; ++q) {
        const int R = (it0 + q) * 32 + rsub, hh = R >> 6, ts = R & 63, tok = tok0 + ts;
        float f[8]; unpack8(vv[q], f);
        const f32x4 r0 = rr[q][0], r1 = rr[q][1], r2 = rr[q][2], r3 = rr[q][3];
        const float cs[8] = {r0[0], r0[2], r1[0], r1[2], r2[0], r2[2], r3[0], r3[2]};
        const float sn[8] = {r0[1], r0[3], r1[1], r1[3], r2[1], r2[3], r3[1], r3[3]};
        const float sgn = (c & 8) ? 1.0f : -1.0f;
#pragma unroll
        for (int j = 0; j < 8; ++j) { const float pr = __shfl_xor(f[j], 8); f[j] = (f[j] * cs[j] + sgn * pr * sn[j]) * qs; }
        const u32x4 o = pack8(f);
        *(u32x4*)(Z + (size_t)tok * kINW + (hh < 4 ? ZC_RQ + hh * 128 : ZC_RK + (hh - 4) * 128) + 8 * c) = o;
      }
    }
  }
}

__device__ __forceinline__ void attn_phase(const Params& p, int l, LAS unsigned char* lds, int tid, int G) {
  const int lane = tid & 63, wave = tid >> 6, l31 = lane & 31, hh = lane >> 5;
  const bf16_t* Z = (const bf16_t*)(p.ws + WS_Z);
  const bf16_t* AVT = (const bf16_t*)(p.ws + WS_AVT);
  bf16_t* YC = (bf16_t*)(p.ws + WS_H);
  const float* qn = p.in[18] + l * 128; const float* kn = p.in[19] + l * 128; const float* sink = p.in[20] + l * 8;
  const float mq = wave_max(fmaxf(fabsf(qn[lane]), fabsf(qn[lane + 64]))), mk = wave_max(fmaxf(fabsf(kn[lane]), fabsf(kn[lane + 64])));
  const float smax = 11.313708499f * mq * mk * 1.01f + 0.1f;
  LAS unsigned char* Pw = lds + 69632 + wave * 4608;
  LAS float* Dn = (LAS float*)(lds + 69632 + 8 * 4608 + wave * 128);
  __syncthreads();
  const int vcu = (G % 8 == 0) ? ((int)blockIdx.x % 8) * (G / 8) + (int)blockIdx.x / 8 : (int)blockIdx.x;
  const int upb = (1024 + G - 1) / G;
  for (int ui = 0; ui < upb; ++ui) {
    const int unit = vcu * upb + ui;
    if (unit >= 1024) break;
    const int qb = unit & 31, kvh = (unit >> 5) & 1, b = unit >> 6;
    const int hq = kvh * 4 + (wave >> 1), q0 = qb * 64 + (wave & 1) * 32;
    const float sk = sink[hq] * 1.4426950408889634f, shift = fmaxf(smax * 1.4426950408889634f, sk);
    const bf16_t* qrow = Z + (size_t)(b * 2048 + q0 + l31) * kINW + ZC_AQ + hq * 128 + 8 * hh;
    bf16x8 Qf[8];
#pragma unroll
    for (int ks = 0; ks < 8; ++ks) Qf[ks] = ldg8(qrow + 16 * ks);
    {
      const float* rp = (const float*)(p.ws + WS_RA) + ((size_t)(b * 2048 + q0 + l31) * 16 + 8 * hh) * 2;
      const f32x4 r0 = *(const f32x4*)rp, r1 = *(const f32x4*)(rp + 4), r2 = *(const f32x4*)(rp + 8), r3 = *(const f32x4*)(rp + 12);
      const f32x4 wl0 = *(const f32x4*)(qn + 8 * hh), wl1 = *(const f32x4*)(qn + 8 * hh + 4), wh0 = *(const f32x4*)(qn + 16 + 8 * hh), wh1 = *(const f32x4*)(qn + 16 + 8 * hh + 4);
      float ssq = 0.f;
#pragma unroll
      for (int ks = 0; ks < 8; ++ks) { float f[8]; unpack8(__builtin_bit_cast(u32x4, Qf[ks]), f);
#pragma unroll
        for (int j = 0; j < 8; ++j) ssq += f[j] * f[j]; }
      ssq += __shfl_xor(ssq, 32);
      const float sc = rsqrtf(ssq * (1.0f / 128.0f) + 1e-6f) * (0.08838834764831845f * 1.4426950408889634f);
#pragma unroll
      for (int ks = 2; ks < 8; ++ks) { float f[8]; unpack8(__builtin_bit_cast(u32x4, Qf[ks]), f);
#pragma unroll
        for (int j = 0; j < 8; ++j) f[j] *= sc;
        Qf[ks] = __builtin_bit_cast(bf16x8, pack8(f)); }
      float x1[8], x2[8]; unpack8(__builtin_bit_cast(u32x4, Qf[0]), x1); unpack8(__builtin_bit_cast(u32x4, Qf[1]), x2);
      const float cs[8] = {r0[0], r0[2], r1[0], r1[2], r2[0], r2[2], r3[0], r3[2]};
      const float sn[8] = {r0[1], r0[3], r1[1], r1[3], r2[1], r2[3], r3[1], r3[3]};
      const float wl[8] = {wl0[0], wl0[1], wl0[2], wl0[3], wl1[0], wl1[1], wl1[2], wl1[3]};
      const float wh[8] = {wh0[0], wh0[1], wh0[2], wh0[3], wh1[0], wh1[1], wh1[2], wh1[3]};
#pragma unroll
      for (int j = 0; j < 8; ++j) { const float a = x1[j] * sc * wl[j], bq = x2[j] * sc * wh[j]; x1[j] = a * cs[j] - bq * sn[j]; x2[j] = bq * cs[j] + a * sn[j]; }
      Qf[0] = __builtin_bit_cast(bf16x8, pack8(x1)); Qf[1] = __builtin_bit_cast(bf16x8, pack8(x2));
    }
    f32x16 O[4];
#pragma unroll
    for (int nt = 0; nt < 4; ++nt) O[nt] = zero16();
    float lsum = 0.f;
    const int qpos = q0 + l31;
    const int kt_lo = qb >= 2 ? 0 : 2 - qb, kt_hi = (33 - qb) < 4 ? (33 - qb) : 4;
    const int kr_ = tid >> 4, kc8 = (tid & 15) * 8;
    const bf16_t* kgp = Z + (long)(b * 2048 + qb * 64 - 128 + kr_) * (long)kINW + ZC_AK + kvh * 128 + kc8;
    const bf16_t* vgp = kgp + (ZC_AV - ZC_AK);
    u32x4 kreg[2], vreg[2];
#pragma unroll
    for (int i = 0; i < 2; ++i) { kreg[i] = *(const u32x4*)(kgp + (long)(kt_lo * 64 + i * 32) * (long)kINW); vreg[i] = *(const u32x4*)(vgp + (long)(kt_lo * 64 + i * 32) * (long)kINW); }
#pragma unroll
    for (int i = 0; i < 2; ++i) { *(LAS u32x4*)(lds + ((kr_ + i * 32) * 136 + kc8) * 2) = kreg[i]; *(LAS u32x4*)(lds + 17408 + ((kr_ + i * 32) * 136 + kc8) * 2) = vreg[i]; }
    if (kt_lo < kt_hi) {
#pragma unroll
      for (int i = 0; i < 2; ++i) { kreg[i] = *(const u32x4*)(kgp + (long)((kt_lo + 1) * 64 + i * 32) * (long)kINW); vreg[i] = *(const u32x4*)(vgp + (long)((kt_lo + 1) * 64 + i * 32) * (long)kINW); }
    }
    __syncthreads();
    for (int kt = kt_lo; kt <= kt_hi; ++kt) {
      const int key0 = qb * 64 - 128 + kt * 64;
      LAS unsigned char* Ks = lds + ((kt - kt_lo) & 1) * 34816;
      LAS unsigned char* Vs = Ks + 17408;
      f32x16 St[2]; St[0] = zero16(); St[1] = zero16();
#pragma unroll
      for (int ks = 0; ks < 8; ++ks)
#pragma unroll
        for (int mt = 0; mt < 2; ++mt) St[mt] = mfma32(lds8(Ks + ((32 * mt + l31) * 136 + 16 * ks + 8 * hh) * 2), Qf[ks], St[mt]);
      if (kt == 0 || kt == 4) {
#pragma unroll
        for (int mt = 0; mt < 2; ++mt)
#pragma unroll
          for (int r = 0; r < 16; ++r) {
            const int key = key0 + 32 * mt + (r & 3) + 8 * (r >> 2) + 4 * hh, dlt = key - qpos;
            const float pv = (dlt <= 128 && dlt >= -128) ? __builtin_amdgcn_exp2f(St[mt][r] - shift) : 0.f;
            lsum += pv; St[mt][r] = pv;
          }
      } else {
#pragma unroll
        for (int mt = 0; mt < 2; ++mt)
#pragma unroll
          for (int r = 0; r < 16; ++r) { const float pv = __builtin_amdgcn_exp2f(St[mt][r] - shift); lsum += pv; St[mt][r] = pv; }
      }
#pragma unroll
      for (int mt = 0; mt < 2; ++mt)
#pragma unroll
        for (int g4 = 0; g4 < 4; ++g4) {
          u32x2 w; w.x = pk2(St[mt][4 * g4], St[mt][4 * g4 + 1]); w.y = pk2(St[mt][4 * g4 + 2], St[mt][4 * g4 + 3]);
          *(LAS u32x2*)(Pw + (l31 * 72 + 32 * mt + 8 * g4 + 4 * hh) * 2) = w;
        }
#pragma unroll
      for (int ks = 0; ks < 4; ++ks) {
        const bf16x8 a = lds8(Pw + (l31 * 72 + 16 * ks + 8 * hh) * 2);
        const unsigned vbase = (unsigned)(size_t)Vs + (unsigned)(((16 * ks + 8 * hh + ((lane & 15) >> 2)) * 136 + 16 * ((lane >> 4) & 1) + 4 * (lane & 3)) * 2);
        u16x4 tr[8];
        TR_READ8(tr, vbase, 0, 1088, 64, 1152, 128, 1216, 192, 1280);
#pragma unroll
        for (int nt = 0; nt < 4; ++nt) O[nt] = mfma32(a, tr_join(tr[2 * nt], tr[2 * nt + 1]), O[nt]);
      }
      if (kt < kt_hi) {
        LAS unsigned char* Kn = lds + ((kt + 1 - kt_lo) & 1) * 34816;
#pragma unroll
        for (int i = 0; i < 2; ++i) { *(LAS u32x4*)(Kn + ((kr_ + i * 32) * 136 + kc8) * 2) = kreg[i]; *(LAS u32x4*)(Kn + 17408 + ((kr_ + i * 32) * 136 + kc8) * 2) = vreg[i]; }
        if (kt + 1 < kt_hi) {
#pragma unroll
          for (int i = 0; i < 2; ++i) { kreg[i] = *(const u32x4*)(kgp + (long)((kt + 2) * 64 + i * 32) * (long)kINW); vreg[i] = *(const u32x4*)(vgp + (long)((kt + 2) * 64 + i * 32) * (long)kINW); }
        }
      }
      __syncthreads();
    }
    lsum += __shfl_xor(lsum, 32);
    const float denom = lsum + exp2f(sk - shift);
    if (lane < 32) Dn[lane] = 1.0f / denom;
#pragma unroll
    for (int g4 = 0; g4 < 4; ++g4) {
      const f32x4 inv4 = *(LAS f32x4*)(Dn + 8 * g4 + 4 * hh);
      bf16_t gts[4][4];
#pragma unroll
      for (int j = 0; j < 4; ++j)
#pragma unroll
        for (int nt = 0; nt < 4; ++nt) gts[j][nt] = Z[(size_t)(b * 2048 + q0 + 8 * g4 + 4 * hh + j) * kINW + ZC_AG + hq * 128 + 32 * nt + l31];
#pragma unroll
      for (int j = 0; j < 4; ++j)
#pragma unroll
        for (int nt = 0; nt < 4; ++nt)
          YC[(size_t)(b * 2048 + q0 + 8 * g4 + 4 * hh + j) * 2048 + 512 + hq * 128 + 32 * nt + l31] = (bf16_t)f2bf(O[nt][4 * g4 + j] * inv4[j] * bf2f(gts[j][nt]));
    }
  }
}

__device__ __forceinline__ void retstate_phase(const Params& p, LAS unsigned char* lds, int tid, int G) {
  const int lane = tid & 63, wave = tid >> 6, l31 = lane & 31, hh = lane >> 5;
  const bf16_t* Z = (const bf16_t*)(p.ws + WS_Z);
  const int er = wave >> 2, dc = wave & 3;
  const int sr = tid >> 4, sc8 = (tid & 15) * 8;
  const int vr = tid >> 3, vc8 = (tid & 7) * 8;
  const int trq = (lane & 15) >> 2, trb = (lane >> 4) & 1, trp = lane & 3;
  for (int unit = blockIdx.x; unit < 256; unit += G) {
    const int eh = unit & 1, dir = (unit >> 1) & 1, h = (unit >> 2) & 3, b = unit >> 4;
    const float lg = lgam2(h);
    const float gch = exp2f(128.0f * lg);
    const bf16_t* kb = Z + ((size_t)b * 2048 + sr) * kINW + ZC_RK + h * 128 + sc8;
    const bf16_t* vb = Z + ((size_t)b * 2048 + vr) * kINW + ZC_RV + h * 128 + 64 * eh + vc8;
    bf16_t* S = (bf16_t*)(p.ws + (dir ? WS_SF : WS_SP));
    const int e = 64 * eh + 32 * er + l31;
    float wk[4];
#pragma unroll
    for (int i = 0; i < 4; ++i) { const int j = sr + 32 * i; wk[i] = exp2f(lg * (float)(dir ? j : 127 - j)); }
    f32x16 acc = zero16();
    u32x4 r0k[4], r0v[2], r1k[4], r1v[2];
#define RS_LOAD(RK, RV, ST) do { const int n_ = dir ? 15 - (ST) : (ST); \
      _Pragma("unroll") for (int i = 0; i < 4; ++i) RK[i] = *(const u32x4*)(kb + (size_t)(n_ * 128 + i * 32) * kINW); \
      _Pragma("unroll") for (int i = 0; i < 2; ++i) RV[i] = *(const u32x4*)(vb + (size_t)(n_ * 128 + i * 64) * kINW); } while (0)
#define RS_STEP(RK, RV, BUF, ST) do { \
      LAS unsigned char* Kt = lds + (BUF) * 69632; LAS unsigned char* Vt = Kt + 34816; \
      _Pragma("unroll") for (int i = 0; i < 4; ++i) { float f_[8]; unpack8(RK[i], f_); _Pragma("unroll") for (int j = 0; j < 8; ++j) f_[j] *= wk[i]; \
        *(LAS u32x4*)(Kt + ((sr + 32 * i) * 136 + sc8) * 2) = pack8(f_); } \
      _Pragma("unroll") for (int i = 0; i < 2; ++i) *(LAS u32x4*)(Vt + ((vr + 64 * i) * 136 + vc8) * 2) = RV[i]; \
      __syncthreads(); \
      if ((ST) + 2 < 16) RS_LOAD(RK, RV, (ST) + 2); \
      const int n = dir ? 15 - (ST) : (ST); \
      bf16_t* so = S + (((size_t)(b * 4 + h) * 16 + n) * 128 + e) * 128 + 32 * dc + 4 * hh; \
      _Pragma("unroll") for (int g4 = 0; g4 < 4; ++g4) { u32x2 w; w.x = pk2(acc[4 * g4], acc[4 * g4 + 1]); w.y = pk2(acc[4 * g4 + 2], acc[4 * g4 + 3]); *(u32x2*)(so + 8 * g4) = w; } \
      _Pragma("unroll") for (int r = 0; r < 16; ++r) acc[r] *= gch; \
      const unsigned ka_ = (unsigned)(size_t)Kt + (unsigned)(((8 * hh + trq) * 136 + 32 * dc + 16 * trb + 4 * trp) * 2); \
      const unsigned va_ = (unsigned)(size_t)Vt + (unsigned)(((8 * hh + trq) * 136 + 32 * er + 16 * trb + 4 * trp) * 2); \
      { u16x4 ta[16], tb[16]; f32x16 acc2 = zero16(); \
        TR_READ16(ta, ka_, 0, 1088, 4352, 5440, 8704, 9792, 13056, 14144, 17408, 18496, 21760, 22848, 26112, 27200, 30464, 31552); \
        TR_READ16(tb, va_, 0, 1088, 4352, 5440, 8704, 9792, 13056, 14144, 17408, 18496, 21760, 22848, 26112, 27200, 30464, 31552); \
        _Pragma("unroll") for (int ks = 0; ks < 8; ks += 2) { \
          acc = mfma32(tr_join(ta[2 * ks], ta[2 * ks + 1]), tr_join(tb[2 * ks], tb[2 * ks + 1]), acc); \
          acc2 = mfma32(tr_join(ta[2 * ks + 2], ta[2 * ks + 3]), tr_join(tb[2 * ks + 2], tb[2 * ks + 3]), acc2); } \
        _Pragma("unroll") for (int r = 0; r < 16; ++r) acc[r] += acc2[r]; } } while (0)
    RS_LOAD(r0k, r0v, 0); RS_LOAD(r1k, r1v, 1);
    __syncthreads();
#pragma unroll 1
    for (int st = 0; st < 16; st += 2) { RS_STEP(r0k, r0v, 0, st); RS_STEP(r1k, r1v, 1, st + 1); }
#undef RS_STEP
#undef RS_LOAD
  }
}

__device__ __forceinline__ void retout_phase(const Params& p, int l, LAS unsigned char* lds, int tid, int G) {
  const int lane = tid & 63, wave = tid >> 6, l31 = lane & 31, hh = lane >> 5;
  const bf16_t* Z = (const bf16_t*)(p.ws + WS_Z);
  const bf16_t* RVT = (const bf16_t*)(p.ws + WS_RVT);
  const bf16_t* SP = (const bf16_t*)(p.ws + WS_SP); const bf16_t* SF = (const bf16_t*)(p.ws + WS_SF);
  bf16_t* YC = (bf16_t*)(p.ws + WS_H);
  const float* gnw = p.in[21] + l * 512;
  LAS unsigned char* R0 = lds;
  LAS unsigned char* R1 = lds + 34816;
  LAS unsigned char* R2 = lds + 69632;
  LAS unsigned char* R3 = lds + 104448;
  LAS float* Of = (LAS float*)lds;
  const int ri = wave >> 1, hf = wave & 1;
  const int sr = tid >> 4, sc8 = (tid & 15) * 8;
  for (int unit = blockIdx.x; unit < 1024; unit += G) {
    const int h = unit & 3, n = (unit >> 2) & 15, b = unit >> 6;
    const size_t tokb = (size_t)b * 2048 + n * 128;
    const float lg2 = lgam2(h);
    u32x4 tq[4], tk[4], tv[4], tp[4], tf[4];
#pragma unroll
    for (int i = 0; i < 4; ++i) {
      const int row = sr + 32 * i;
      tq[i] = *(const u32x4*)(Z + (tokb + row) * kINW + ZC_RQ + h * 128 + sc8);
      tk[i] = *(const u32x4*)(Z + (tokb + row) * kINW + ZC_RK + h * 128 + sc8);
      tv[i] = *(const u32x4*)(Z + (tokb + row) * kINW + ZC_RV + h * 128 + sc8);
    }
    __syncthreads();
#pragma unroll
    for (int i = 0; i < 4; ++i) {
      const int off = ((sr + 32 * i) * 136 + sc8) * 2;
      *(LAS u32x4*)(R0 + off) = tq[i]; *(LAS u32x4*)(R1 + off) = tk[i]; *(LAS u32x4*)(R3 + off) = tv[i];
    }
#pragma unroll
    for (int i = 0; i < 4; ++i) {
      const int row = sr + 32 * i;
      tp[i] = *(const u32x4*)(SP + (((size_t)(b * 4 + h) * 16 + n) * 128 + row) * 128 + sc8);
      tf[i] = *(const u32x4*)(SF + (((size_t)(b * 4 + h) * 16 + n) * 128 + row) * 128 + sc8);
    }
    __syncthreads();
    const int iq = 32 * ri + l31;
    bf16x8 Qf[8];
#pragma unroll
    for (int ks = 0; ks < 8; ++ks) Qf[ks] = lds8(R0 + (iq * 136 + 16 * ks + 8 * hh) * 2);
#pragma unroll
    for (int mt = 0; mt < 2; ++mt) {
      f32x16 acc = zero16();
#pragma unroll
      for (int ks = 0; ks < 8; ++ks) acc = mfma32(lds8(R1 + ((64 * hf + 32 * mt + l31) * 136 + 16 * ks + 8 * hh) * 2), Qf[ks], acc);
#pragma unroll
      for (int g4 = 0; g4 < 4; ++g4) {
        const int j0 = 64 * hf + 32 * mt + 8 * g4 + 4 * hh;
        float v[4];
#pragma unroll
        for (int jj = 0; jj < 4; ++jj) { const int dl = iq - (j0 + jj); v[jj] = acc[4 * g4 + jj] * __builtin_amdgcn_exp2f(lg2 * (float)(dl < 0 ? -dl : dl)); }
        u32x2 w; w.x = pk2(v[0], v[1]); w.y = pk2(v[2], v[3]);
        *(LAS u32x2*)(R2 + (iq * 136 + j0) * 2) = w;
      }
    }
    __syncthreads();
#pragma unroll
    for (int i = 0; i < 4; ++i) *(LAS u32x4*)(R1 + ((sr + 32 * i) * 136 + sc8) * 2) = tp[i];
    __syncthreads();
    f32x16 acc[2]; acc[0] = zero16(); acc[1] = zero16();
#pragma unroll
    for (int nt = 0; nt < 2; ++nt)
#pragma unroll
      for (int ks = 0; ks < 8; ++ks) acc[nt] = mfma32(Qf[ks], lds8(R1 + ((64 * hf + 32 * nt + l31) * 136 + 16 * ks + 8 * hh) * 2), acc[nt]);
#pragma unroll
    for (int r = 0; r < 16; ++r) {
      const int il = 32 * ri + (r & 3) + 8 * (r >> 2) + 4 * hh;
      const float rt = exp2f(lg2 * (float)(2 * il + 1 - 128));
      acc[0][r] *= rt; acc[1][r] *= rt;
    }
    __syncthreads();
#pragma unroll
    for (int i = 0; i < 4; ++i) *(LAS u32x4*)(R1 + ((sr + 32 * i) * 136 + sc8) * 2) = tf[i];
    __syncthreads();
#pragma unroll
    for (int nt = 0; nt < 2; ++nt)
#pragma unroll
      for (int ks = 0; ks < 8; ++ks) acc[nt] = mfma32(Qf[ks], lds8(R1 + ((64 * hf + 32 * nt + l31) * 136 + 16 * ks + 8 * hh) * 2), acc[nt]);
#pragma unroll
    for (int r = 0; r < 16; ++r) {
      const int il = 32 * ri + (r & 3) + 8 * (r >> 2) + 4 * hh;
      const float fw = exp2f(lg2 * (float)(128 - il));
      acc[0][r] *= fw; acc[1][r] *= fw;
    }
#pragma unroll
    for (int m2 = 0; m2 < 4; ++m2) {
      const unsigned vbase = (unsigned)(size_t)R3 + (unsigned)(((32 * m2 + 8 * hh + ((lane & 15) >> 2)) * 136 + 64 * hf + 16 * ((lane >> 4) & 1) + 4 * (lane & 3)) * 2);
      u16x4 tr[8];
      TR_READ8(tr, vbase, 0, 1088, 64, 1152, 4352, 5440, 4416, 5504);
#pragma unroll
      for (int k2 = 0; k2 < 2; ++k2) {
        const bf16x8 a = lds8(R2 + (iq * 136 + 16 * (2 * m2 + k2) + 8 * hh) * 2);
#pragma unroll
        for (int nt = 0; nt < 2; ++nt) acc[nt] = mfma32(a, tr_join(tr[4 * k2 + 2 * nt], tr[4 * k2 + 2 * nt + 1]), acc[nt]);
      }
    }
    __syncthreads();
#pragma unroll
    for (int nt = 0; nt < 2; ++nt)
#pragma unroll
      for (int r = 0; r < 16; ++r) Of[(32 * ri + (r & 3) + 8 * (r >> 2) + 4 * hh) * 132 + 64 * hf + 32 * nt + l31] = acc[nt][r];
    __syncthreads();
    {
      const int c = lane & 15, rs4 = lane >> 4;
      float wn[8];
      { const f32x4 a = *(const f32x4*)(gnw + h * 128 + 8 * c), bq = *(const f32x4*)(gnw + h * 128 + 8 * c + 4);
        wn[0] = a[0]; wn[1] = a[1]; wn[2] = a[2]; wn[3] = a[3]; wn[4] = bq[0]; wn[5] = bq[1]; wn[6] = bq[2]; wn[7] = bq[3]; }
      u32x4 gv[4], ov[4];
#pragma unroll
      for (int ps = 0; ps < 4; ++ps) gv[ps] = *(const u32x4*)(Z + (tokb + 16 * wave + 4 * ps + rs4) * kINW + ZC_RG + h * 128 + 8 * c);
#pragma unroll
      for (int ps = 0; ps < 4; ++ps) {
        const int row = 16 * wave + 4 * ps + rs4;
        const f32x4 x0 = *(const LAS f32x4*)(Of + row * 132 + 8 * c), x1 = *(const LAS f32x4*)(Of + row * 132 + 8 * c + 4);
        float f[8] = {x0[0], x0[1], x0[2], x0[3], x1[0], x1[1], x1[2], x1[3]};
        float sm = 0.f;
#pragma unroll
        for (int j = 0; j < 8; ++j) sm += f[j];
        sm += __shfl_xor(sm, 1); sm += __shfl_xor(sm, 2); sm += __shfl_xor(sm, 4); sm += __shfl_xor(sm, 8);
        const float mu = sm * (1.0f / 128.0f);
        float vs = 0.f;
#pragma unroll
        for (int j = 0; j < 8; ++j) { f[j] -= mu; vs += f[j] * f[j]; }
        vs += __shfl_xor(vs, 1); vs += __shfl_xor(vs, 2); vs += __shfl_xor(vs, 4); vs += __shfl_xor(vs, 8);
        const float rs = rsqrtf(vs * (1.0f / 128.0f) + 1e-6f);
        float fg[8]; unpack8(gv[ps], fg);
#pragma unroll
        for (int j = 0; j < 8; ++j) f[j] = f[j] * rs * wn[j] * fg[j];
        ov[ps] = pack8(f);
      }
#pragma unroll
      for (int ps = 0; ps < 4; ++ps) *(u32x4*)(YC + (tokb + 16 * wave + 4 * ps + rs4) * 2048 + 1536 + h * 128 + 8 * c) = ov[ps];
    }
  }
}

__device__ __forceinline__ void s5_phase(const Params& p, int l, LAS unsigned char* lds, int tid, int G) {
  const int lane = tid & 63, wave = tid >> 6, l31 = lane & 31, hh = lane >> 5;
  const bf16_t* Z = (const bf16_t*)(p.ws + WS_Z);
  bf16_t* YS = (bf16_t*)(p.ws + WS_YS);
  LAS unsigned char* Us = lds;
  LAS float* Hc = (LAS float*)(lds + 67584);
  for (int unit = blockIdx.x; unit < 512; unit += G) {
    const int g = unit & 31, b = unit >> 5;
    const bf16_t* EEp = (const bf16_t*)(p.ws + WS_EE) + (size_t)(l * 32 + g) * 65536;
    const bf16_t* MFp = (const bf16_t*)(p.ws + WS_MF) + (size_t)(l * 32 + g) * 131072;
    const bf16_t* mrow = MFp + (32 * wave + l31) * 512 + 8 * hh;
    __syncthreads();
    {
      u32x4 uv[8];
#pragma unroll
      for (int i = 0; i < 8; ++i) { const int idx = tid + 512 * i, tok = idx >> 1, half = idx & 1; uv[i] = *(const u32x4*)(Z + (size_t)(b * 2048 + tok) * kINW + g * 16 + half * 8); }
#pragma unroll
      for (int i = 0; i < 8; ++i) { const int idx = tid + 512 * i, tok = idx >> 1, half = idx & 1; *(LAS u32x4*)(Us + (tok >> 4) * 528 + (tok & 15) * 32 + half * 16) = uv[i]; }
    }
    __syncthreads();
    f32x16 acc[4];
#pragma unroll
    for (int nt = 0; nt < 4; ++nt) acc[nt] = zero16();
#pragma unroll 1
    for (int dir = 0; dir < 2; ++dir) {
      {
        const int rt = wave >> 1, ct0 = (wave & 1) * 2;
        f32x16 a2[2]; a2[0] = zero16(); a2[1] = zero16();
        const bf16_t* arow = EEp + (dir * 128 + 32 * rt + l31) * 256 + 8 * hh;
#pragma unroll
        for (int ks = 0; ks < 16; ++ks) {
          const bf16x8 a = ldg8(arow + 16 * ks);
#pragma unroll
          for (int t2 = 0; t2 < 2; ++t2) a2[t2] = mfma32(a, lds8(Us + (32 * (ct0 + t2) + l31) * 528 + ks * 32 + hh * 16), a2[t2]);
        }
#pragma unroll
        for (int t2 = 0; t2 < 2; ++t2)
#pragma unroll
          for (int g4 = 0; g4 < 4; ++g4) {
            f32x4 v; v[0] = a2[t2][4 * g4]; v[1] = a2[t2][4 * g4 + 1]; v[2] = a2[t2][4 * g4 + 2]; v[3] = a2[t2][4 * g4 + 3];
            *(LAS f32x4*)(Hc + (32 * (ct0 + t2) + l31) * 132 + 32 * rt + 8 * g4 + 4 * hh) = v;
          }
      }
      __syncthreads();
      if (wave == 0) {
        const float* a16 = (const float*)(p.ws + WS_A16) + ((size_t)((l * 32 + g) * 2 + dir) * 64 + lane) * 2;
        const float ar = a16[0], ai = a16[1];
        float cr = 0.f, ci = 0.f;
        for (int c8 = 0; c8 < 16; ++c8) {
          float hr[8], hi[8];
#pragma unroll
          for (int j = 0; j < 8; ++j) { const int c = dir ? 127 - (c8 * 8 + j) : c8 * 8 + j; hr[j] = Hc[c * 132 + lane]; hi[j] = Hc[c * 132 + 64 + lane]; }
#pragma unroll
          for (int j = 0; j < 8; ++j) {
            const int c = dir ? 127 - (c8 * 8 + j) : c8 * 8 + j;
            Hc[c * 132 + lane] = cr; Hc[c * 132 + 64 + lane] = ci;
            const float nr = ar * cr - ai * ci + hr[j], ni = ar * ci + ai * cr + hi[j];
            cr = nr; ci = ni;
          }
        }
      }
      if (dir == 0) {
        for (int ks = 0; ks < 16; ++ks) {
          const bf16x8 a = ldg8(mrow + 16 * ks);
#pragma unroll
          for (int nt = 0; nt < 4; ++nt) acc[nt] = mfma32(a, lds8(Us + (32 * nt + l31) * 528 + ks * 32 + hh * 16), acc[nt]);
        }
      }
      __syncthreads();
      for (int ks = 0; ks < 8; ++ks) {
        const bf16x8 a = ldg8(mrow + 256 + dir * 128 + 16 * ks);
#pragma unroll
        for (int nt = 0; nt < 4; ++nt) {
          const LAS float* cp = Hc + (32 * nt + l31) * 132 + 16 * ks + 8 * hh;
          const f32x4 c0 = *(const LAS f32x4*)cp, c1 = *(const LAS f32x4*)(cp + 4);
          u32x4 w; w.x = pk2(c0[0], c0[1]); w.y = pk2(c0[2], c0[3]); w.z = pk2(c1[0], c1[1]); w.w = pk2(c1[2], c1[3]);
          acc[nt] = mfma32(a, __builtin_bit_cast(bf16x8, w), acc[nt]);
        }
      }
      __syncthreads();
    }
#pragma unroll
    for (int nt = 0; nt < 4; ++nt)
#pragma unroll
      for (int g4 = 0; g4 < 4; ++g4) {
        const int row0 = 32 * wave + 8 * g4 + 4 * hh, i = row0 >> 4, p0 = row0 & 15, c = 32 * nt + l31;
        const size_t tok = (size_t)b * 2048 + 16 * c + i;
        u32x2 w; w.x = pk2(gelu_tanh_f(acc[nt][4 * g4]), gelu_tanh_f(acc[nt][4 * g4 + 1])); w.y = pk2(gelu_tanh_f(acc[nt][4 * g4 + 2]), gelu_tanh_f(acc[nt][4 * g4 + 3]));
        *(u32x2*)(YS + tok * 512 + g * 16 + p0) = w;
      }
  }
}

extern __shared__ __attribute__((aligned(16))) unsigned char dyn_lds[];
__global__ void __launch_bounds__(512, 2) mega(Params p) {
  cg::grid_group grid = cg::this_grid();
  LAS unsigned char* lds = (LAS unsigned char*)dyn_lds;
  volatile LAS unsigned* bst = (volatile LAS unsigned*)(lds + kLdsBytes - 64);
  if (threadIdx.x < 16) bst[threadIdx.x] = 0u;
  __syncthreads();
  (void)xcd_barrier_post((unsigned*)(p.ws + WS_CTL), bst);
#define GSYNC() do { XcdBarrier xb_; xb_.bar = (unsigned*)(p.ws + WS_CTL); xb_.x = xb_xcc_id(); xb_.st = bst; xcd_barrier(xb_); } while (0)
  const int G = gridDim.x;
#define tid opaque_tid()
#define WSL() ({ Params q_ = p; __attribute__((address_space(1))) unsigned char* g_ = (__attribute__((address_space(1))) unsigned char*)q_.ws; asm volatile("" : "+s"(g_)); q_.ws = (unsigned char*)g_; q_; })
#ifndef PHMASK
#define PHMASK 0xFFFF
#endif
#ifndef REPMASK
#define REPMASK 0
#endif
#ifndef XSYNC
#define XSYNC 0
#endif
#if PHMASK & 1
  phase0(WSL(), lds, tid, G);
#if REPMASK & 1
  phase0(WSL(), lds, tid, G);
#endif
#endif
  if (p.ws == nullptr) grid.sync();
  GSYNC();
  for (int l = 0; l < 2; ++l) {
    const float* xin = l == 0 ? p.in[0] : p.out;
#if PHMASK & 2
    norm_phase(WSL(), l, xin, tid, G);
#if REPMASK & 2
    norm_phase(WSL(), l, xin, tid, G);
#endif
#endif
    GSYNC();
#if PHMASK & 4
    {
      const Params q = WSL();
      pg8::Gemm g{(const bf16_t*)(q.ws + WS_H), (const bf16_t*)(q.ws + WS_WIN) + (size_t)l * 5632 * 2048, kT, kINW, 2048};
      pg8::StaticOrder S; S.init(kT, kINW, G, (int)blockIdx.x);
      EpiZ E{(bf16_t*)(q.ws + WS_Z)};
      pg8::gemm_phase<EpiZ, pg8::StaticOrder, true, true>(lds, g, S, E);
#if REPMASK & 4
      pg8::gemm_phase<EpiZ, pg8::StaticOrder, true, true>(lds, g, S, E);
#endif
    }
#endif
    GSYNC();
#if PHMASK & 8
    prep_phase(WSL(), l, lds, tid, G);
#endif
    GSYNC();
#if PHMASK & 16
    attn_phase(WSL(), l, lds, tid, G);
#if REPMASK & 16
    attn_phase(WSL(), l, lds, tid, G);
#endif
#endif
#if PHMASK & 32
    retstate_phase(WSL(), lds, tid, G);
#if REPMASK & 32
    retstate_phase(WSL(), lds, tid, G);
#endif
#endif
#if PHMASK & 64
    s5_phase(WSL(), l, lds, tid, G);
#if REPMASK & 64
    s5_phase(WSL(), l, lds, tid, G);
#endif
#endif
    GSYNC();
#if PHMASK & 256
    {
      const Params q = WSL();
      pg8::Gemm g{(const bf16_t*)(q.ws + WS_YS), (const bf16_t*)(q.ws + WS_GLU) + (size_t)l * 512 * 512, kT, 512, 512};
      pg8::StaticOrder S; S.init(kT, 512, G, (int)blockIdx.x);
      EpiGlu E{(const bf16_t*)(q.ws + WS_YS), (const bf16_t*)(q.ws + WS_Z), q.in[17] + l * 512, (bf16_t*)(q.ws + WS_H)};
      __syncthreads();
      pg8::gemm_phase<EpiGlu, pg8::StaticOrder, true, true>(lds, g, S, E);
#if REPMASK & 256
      pg8::gemm_phase<EpiGlu, pg8::StaticOrder, true, true>(lds, g, S, E);
#endif
    }
#endif
    __syncthreads();
#if PHMASK & 512
    retout_phase(WSL(), l, lds, tid, G);
#if REPMASK & 512
    retout_phase(WSL(), l, lds, tid, G);
#endif
#endif
    GSYNC();
#if PHMASK & 1024
    {
      const Params q = WSL();
      pg8::Gemm g{(const bf16_t*)(q.ws + WS_H), (const bf16_t*)(q.ws + WS_WOUT) + (size_t)l * 2048 * 2048, kT, 2048, 2048};
      pg8::StaticOrder S; S.init(kT, 2048, G, (int)blockIdx.x);
      EpiOut E{xin, q.out, (const float*)(q.ws + WS_ADA) + (size_t)l * 16 * 6144 + 4096};
      __syncthreads();
      pg8::gemm_phase<EpiOut, pg8::StaticOrder, true, true>(lds, g, S, E);
#if REPMASK & 1024
      if (l == 0) pg8::gemm_phase<EpiOut, pg8::StaticOrder, true, true>(lds, g, S, E);
#endif
    }
#endif
    GSYNC();
    for (int xs = 0; xs < XSYNC; ++xs) GSYNC();
  }
#undef tid
#undef WSL
}

extern "C" void kernel_launch(void* const* d_in, const int* in_sizes, int n_in, void* d_out, int out_size, void* d_ws, size_t ws_size, hipStream_t stream) {
  static int grid_blocks = 0;
  if (grid_blocks == 0) {
    if (n_in != 22 || ws_size < WS_END) { fprintf(stderr, "kernel_launch: unexpected n_in %d or ws_size %zu (need %zu)\n", n_in, ws_size, (size_t)WS_END); grid_blocks = -1; return; }
    int dev = 0, cus = 0, per_cu = 0;
    (void)hipGetDevice(&dev);
    (void)hipDeviceGetAttribute(&cus, hipDeviceAttributeMultiprocessorCount, dev);
    (void)hipFuncSetAttribute((const void*)mega, hipFuncAttributeMaxDynamicSharedMemorySize, kLdsBytes);
    (void)hipOccupancyMaxActiveBlocksPerMultiprocessor(&per_cu, (const void*)mega, 512, kLdsBytes);
    if (per_cu < 1) fprintf(stderr, "kernel_launch: occupancy query says %d blocks per CU\n", per_cu);
    (void)hipGetLastError();
    grid_blocks = cus;
  }
  if (grid_blocks < 0) return;
  (void)hipMemsetAsync((unsigned char*)d_ws + WS_CTL, 0, CTL_BYTES, stream);
  Params p{};
  for (int i = 0; i < 22; ++i) p.in[i] = (const float*)d_in[i];
  p.out = (float*)d_out; p.ws = (unsigned char*)d_ws;
  void* args[] = {&p};
  hipError_t e = hipLaunchCooperativeKernel((void*)mega, dim3(grid_blocks), dim3(512), args, kLdsBytes, stream);
  if (e != hipSuccess) fprintf(stderr, "cooperative launch failed: %s (grid %d)\n", hipGetErrorString(e), grid_blocks);
}
```

```cpp
#include <hip/hip_runtime.h>
#include <hip/hip_cooperative_groups.h>
#include <cstdio>
#include <cstdint>
namespace cg = cooperative_groups;

#define LAS __attribute__((address_space(3)))
typedef unsigned short bf16_t;
typedef short bf16x8 __attribute__((ext_vector_type(8)));
typedef float f32x4 __attribute__((ext_vector_type(4)));
typedef float f32x2 __attribute__((ext_vector_type(2)));
typedef float f32x16 __attribute__((ext_vector_type(16)));
typedef unsigned u32x4 __attribute__((ext_vector_type(4)));
typedef unsigned u32x2 __attribute__((ext_vector_type(2)));

constexpr int kT = 32768, kD = 2048, kL = 2048, kB = 16, kINW = 5632;
constexpr int kLdsBytes = 144 * 1024;

constexpr int ZC_U = 0, ZC_SG = 512, ZC_AQ = 1024, ZC_AK = 2048, ZC_AV = 2304, ZC_AG = 2560, ZC_RQ = 3584, ZC_RK = 4096, ZC_RV = 4608, ZC_RG = 5120;

__device__ __forceinline__ unsigned f2bf(float f) { unsigned u = __builtin_bit_cast(unsigned, f); return (u + 0x7fffu + ((u >> 16) & 1u)) >> 16; }
__device__ __forceinline__ unsigned pk2(float lo, float hi) { unsigned r; asm("v_cvt_pk_bf16_f32 %0, %1, %2" : "=v"(r) : "v"(lo), "v"(hi)); return r; }
__device__ __forceinline__ float bflo(unsigned w) { return __builtin_bit_cast(float, w << 16); }
__device__ __forceinline__ float bfhi(unsigned w) { return __builtin_bit_cast(float, w & 0xffff0000u); }
__device__ __forceinline__ float bf2f(bf16_t h) { return __builtin_bit_cast(float, ((unsigned)h) << 16); }
__device__ __forceinline__ float silu_f(float v) { return v * __builtin_amdgcn_rcpf(1.0f + __expf(-v)); }
__device__ __forceinline__ float sigmoid_f(float v) { return __builtin_amdgcn_rcpf(1.0f + __expf(-v)); }
__device__ __forceinline__ float gelu_tanh_f(float v) {
  const float u = 0.7978845608028654f * (v + 0.044715f * v * v * v);
  const float e = __expf(2.0f * u);
  const float th = 1.0f - 2.0f * __builtin_amdgcn_rcpf(e + 1.0f);
  return 0.5f * v * (1.0f + th);
}
__device__ __forceinline__ float wave_sum(float v) {
#pragma unroll
  for (int o = 32; o >= 1; o >>= 1) v += __shfl_xor(v, o);
  return v;
}
__device__ __forceinline__ float wave_max(float v) {
#pragma unroll
  for (int o = 32; o >= 1; o >>= 1) v = fmaxf(v, __shfl_xor(v, o));
  return v;
}
__device__ __forceinline__ f32x16 mfma32(bf16x8 a, bf16x8 b, f32x16 c) { return __builtin_amdgcn_mfma_f32_32x32x16_bf16(a, b, c, 0, 0, 0); }
__device__ __forceinline__ f32x16 zero16() { f32x16 z;
#pragma unroll
  for (int i = 0; i < 16; ++i) z[i] = 0.f; return z; }
__device__ __forceinline__ bf16x8 ldg8(const bf16_t* p) { return *(const bf16x8*)p; }
__device__ __forceinline__ bf16x8 lds8(const LAS unsigned char* p) { return *(const LAS bf16x8*)p; }

__device__ __forceinline__ int opaque_tid() { int t = threadIdx.x; asm volatile("" : "+v"(t)); return t; }
typedef unsigned short u16x4 __attribute__((ext_vector_type(4)));
#define TR_READ8(R, BASE, O0, O1, O2, O3, O4, O5, O6, O7) \
  asm volatile("ds_read_b64_tr_b16 %0, %8 offset:" #O0 "\n\tds_read_b64_tr_b16 %1, %8 offset:" #O1 "\n\tds_read_b64_tr_b16 %2, %8 offset:" #O2 "\n\tds_read_b64_tr_b16 %3, %8 offset:" #O3 \
               "\n\tds_read_b64_tr_b16 %4, %8 offset:" #O4 "\n\tds_read_b64_tr_b16 %5, %8 offset:" #O5 "\n\tds_read_b64_tr_b16 %6, %8 offset:" #O6 "\n\tds_read_b64_tr_b16 %7, %8 offset:" #O7 \
               "\n\ts_waitcnt lgkmcnt(0)" \
               : "=&v"(R[0]), "=&v"(R[1]), "=&v"(R[2]), "=&v"(R[3]), "=&v"(R[4]), "=&v"(R[5]), "=&v"(R[6]), "=&v"(R[7]) : "v"(BASE) : "memory")
__device__ __forceinline__ bf16x8 tr_join(u16x4 lo, u16x4 hi) { bf16x8 r; r[0] = (short)lo[0]; r[1] = (short)lo[1]; r[2] = (short)lo[2]; r[3] = (short)lo[3]; r[4] = (short)hi[0]; r[5] = (short)hi[1]; r[6] = (short)hi[2]; r[7] = (short)hi[3]; return r; }
#define TR_READ16(R, BASE, O0, O1, O2, O3, O4, O5, O6, O7, O8, O9, O10, O11, O12, O13, O14, O15) \
  asm volatile("ds_read_b64_tr_b16 %0, %16 offset:" #O0 "\n\tds_read_b64_tr_b16 %1, %16 offset:" #O1 "\n\tds_read_b64_tr_b16 %2, %16 offset:" #O2 "\n\tds_read_b64_tr_b16 %3, %16 offset:" #O3 \
               "\n\tds_read_b64_tr_b16 %4, %16 offset:" #O4 "\n\tds_read_b64_tr_b16 %5, %16 offset:" #O5 "\n\tds_read_b64_tr_b16 %6, %16 offset:" #O6 "\n\tds_read_b64_tr_b16 %7, %16 offset:" #O7 \
               "\n\tds_read_b64_tr_b16 %8, %16 offset:" #O8 "\n\tds_read_b64_tr_b16 %9, %16 offset:" #O9 "\n\tds_read_b64_tr_b16 %10, %16 offset:" #O10 "\n\tds_read_b64_tr_b16 %11, %16 offset:" #O11 \
               "\n\tds_read_b64_tr_b16 %12, %16 offset:" #O12 "\n\tds_read_b64_tr_b16 %13, %16 offset:" #O13 "\n\tds_read_b64_tr_b16 %14, %16 offset:" #O14 "\n\tds_read_b64_tr_b16 %15, %16 offset:" #O15 \
               "\n\ts_waitcnt lgkmcnt(0)" \
               : "=&v"(R[0]), "=&v"(R[1]), "=&v"(R[2]), "=&v"(R[3]), "=&v"(R[4]), "=&v"(R[5]), "=&v"(R[6]), "=&v"(R[7]), "=&v"(R[8]), "=&v"(R[9]), "=&v"(R[10]), "=&v"(R[11]), "=&v"(R[12]), "=&v"(R[13]), "=&v"(R[14]), "=&v"(R[15]) : "v"(BASE) : "memory")

#define XB_TMO      128
#define XB_XCNT(j)  (256  + 64 * (j))
#define XB_XSUB(j)  (1280 + 64 * (j))
#define XB_XGEN(j)  (2304 + 64 * (j))
#define XB_TOP      3328
#define XB_TOPGEN   3392
#define XCD_BAR_WORDS 3456
#define XB_SPIN_CAP (1u << 18)

__device__ __forceinline__ unsigned xb_ld(unsigned* p)              { return __hip_atomic_load(p, __ATOMIC_RELAXED, __HIP_MEMORY_SCOPE_AGENT); }
__device__ __forceinline__ unsigned xb_add(unsigned* p, unsigned v) { return __hip_atomic_fetch_add(p, v, __ATOMIC_RELAXED, __HIP_MEMORY_SCOPE_AGENT); }
__device__ __forceinline__ unsigned xb_xcc_id() { return (unsigned)__builtin_amdgcn_s_getreg((3 << 11) | 20) & 0xFu; }

#define XB_SPIN(cond, bar) do { unsigned _sp = 0; while (cond) { __builtin_amdgcn_s_sleep(1); \
    if ((++_sp & 255u) == 0u) { if (xb_ld(&(bar)[XB_TMO])) break; if (_sp > XB_SPIN_CAP) { atomicAdd(&(bar)[XB_TMO], 1u); break; } } } } while (0)

struct XcdBarrier {
    unsigned* bar; unsigned x;
    volatile LAS unsigned* st;
};


__device__ __forceinline__ XcdBarrier xcd_barrier_post(unsigned* bar, volatile LAS unsigned* st) {
    XcdBarrier b; b.bar = bar; b.x = xb_xcc_id(); b.st = st;
    if (threadIdx.x == 0) (void)xb_add(&bar[XB_XCNT(b.x)], 1u);
    return b;
}


__device__ __forceinline__ void xcd_barrier_complete(unsigned* bar, unsigned x, unsigned& nloc, unsigned& nx) {
    const unsigned G = gridDim.x * gridDim.y * gridDim.z;
    unsigned sum, cnt, mine, sp = 0u;
    for (;;) {
        sum = 0u; cnt = 0u; mine = 0u;
#pragma unroll
        for (unsigned j = 0; j < 16; ++j) { const unsigned c = xb_ld(&bar[XB_XCNT(j)]); sum += c; cnt += (c > 0u) ? 1u : 0u; mine = (j == x) ? c : mine; }
        if (sum == G) break;
        __builtin_amdgcn_s_sleep(1);
        if ((++sp & 255u) == 0u) { if (xb_ld(&bar[XB_TMO])) break; if (sp > XB_SPIN_CAP) { atomicAdd(&bar[XB_TMO], 1u); break; } }
    }
    nloc = mine > 0u ? mine : 1u; nx = cnt > 0u ? cnt : 1u;
}


__device__ __forceinline__ void xcd_barrier(const XcdBarrier& b) {
    asm volatile("s_waitcnt vmcnt(0)" ::: "memory");
    __syncthreads();
    if (threadIdx.x == 0) {
        unsigned* bar = b.bar;
        __builtin_amdgcn_s_waitcnt(0);
        unsigned nloc = b.st[0], nx = b.st[1];
        if (nloc == 0u) { xcd_barrier_complete(bar, b.x, nloc, nx); b.st[0] = nloc; b.st[1] = nx; }
        const unsigned old = xb_add(&bar[XB_XSUB(b.x)], 1u);
        const unsigned gen = old / nloc;
        if (old + 1u == (gen + 1u) * nloc) {
            __builtin_amdgcn_fence(__ATOMIC_RELEASE, "agent");
            asm volatile("s_waitcnt vmcnt(0)" ::: "memory");


            const unsigned og = xb_add(&bar[XB_TOP], 1u);
            const unsigned tg = og / nx;
            if (og + 1u == (tg + 1u) * nx) xb_add(&bar[XB_TOPGEN], 1u);
            else XB_SPIN(xb_ld(&bar[XB_TOPGEN]) == tg, bar);
            __builtin_amdgcn_fence(__ATOMIC_ACQUIRE, "agent");
            xb_add(&bar[XB_XGEN(b.x)], 1u);
            asm volatile("s_waitcnt vmcnt(0)" ::: "memory");

        } else {
            XB_SPIN(xb_ld(&bar[XB_XGEN(b.x)]) == gen, bar);
            __builtin_amdgcn_fence(__ATOMIC_ACQUIRE, "agent");


            asm volatile("s_waitcnt vmcnt(0)" ::: "memory");
        }
    }
    __syncthreads();
}
namespace pg8 {
#define PG8_LAS __attribute__((address_space(3)))
typedef unsigned short bf16_t;
typedef short bf16x8 __attribute__((ext_vector_type(8)));
typedef float f32x4 __attribute__((ext_vector_type(4)));
typedef unsigned u32x4 __attribute__((ext_vector_type(4)));
constexpr int BM = 256, BK = 64, HALF = 128, HTB = HALF * BK * 2  , STAGE_BYTES = 8 * HTB, NXCD = 8, WGM = 8;


__host__ __device__ __forceinline__ int lds_byte(int r, int c) { const int st = (r >> 4) * 2 + (c >> 5), rr = r & 15, cc = c & 31, ob = rr * 64 + cc * 2; return st * 1024 + (ob ^ (((ob >> 9) & 1) << 5)); }
__host__ __device__ __forceinline__ void stage_rc(int b, int& R, int& C) { const int st = b / 1024, sb = b % 1024, swz = sb ^ (((sb >> 9) & 1) << 5); R = (st >> 1) * 16 + swz / 64; C = (st & 1) * 32 + (swz % 64) / 2; }
__host__ __device__ __forceinline__ int perm32(int rho) { const int n = rho >> 4, i = rho & 15; return 8 * (i >> 2) + 4 * n + (i & 3); }
struct Unit { int pm, pn; };
struct Gemm { const bf16_t* A; const bf16_t* Bt; int M, N, K; };
struct StaticOrder {
    int nM, nN, nwg, G, c;
    __host__ __device__ void init(int M, int N, int G_, int c_) { nM = M / BM; nN = N / BM; nwg = nM * nN; G = G_; c = c_; }
    __host__ __device__ bool next(int i, Unit& u) const {
        const long L = (long)i * G + c; if (L >= nwg) return false;
        int wgid = (int)L; { const int q = nwg / NXCD, r = nwg % NXCD, xcd = wgid % NXCD, off = wgid / NXCD; wgid = (xcd < r ? xcd * (q + 1) : r * (q + 1) + (xcd - r) * q) + off; }
        const int nig = WGM * nN, gid = wgid / nig, fm = gid * WGM, gsz = (nM - fm) < WGM ? (nM - fm) : WGM;
        u.pm = fm + ((wgid % nig) % gsz); u.pn = (wgid % nig) / gsz; return true;
    }
    __device__ __forceinline__ void a_ready(const Unit&) const {}
    __device__ __forceinline__ void done(const Unit&) const {}
};
__device__ __forceinline__ unsigned cvt_pk_bf16(float lo, float hi) { unsigned r; asm volatile("v_cvt_pk_bf16_f32 %0, %1, %2" : "=v"(r) : "v"(lo), "v"(hi)); return r; }
template <class Epi, class Sched, bool ALIGN_EPI = false, bool SP2 = false>
__device__ __forceinline__ void gemm_phase(PG8_LAS unsigned char* lds, const Gemm g, const Sched& S, const Epi& E) {
    const int tid = opaque_tid(), wid = __builtin_amdgcn_readfirstlane(tid >> 6), lane = tid & 63, wr = wid >> 2, wc = wid & 3, fr = lane & 15, fq = lane >> 4;
    const int K = g.K, nt = K / BK;

    unsigned voffA[2], voffB[2];
#pragma unroll
    for (int i = 0; i < 2; ++i) { int R, C; stage_rc(tid * 16 + i * 8192, R, C); const int Rb = Epi::PERM ? ((R & ~31) + perm32(R & 31)) : R;
        voffA[i] = (unsigned)(R * K + C) * 2u; voffB[i] = (unsigned)(Rb * K + C) * 2u; }
    const size_t kstep = (size_t)(BK * 2);
    const size_t hstep = (size_t)HALF * K * 2;
    const size_t tstep = 2 * hstep;
    const unsigned ldsw = (unsigned)wid * 1024u;

    const int aoff = lds_byte(wr * 64 + fr, fq * 8), boff = lds_byte(wc * 32 + fr, fq * 8);
#define PG8_SA(b, h) (((b) * 2 + (h)) * HTB)
#define PG8_SB(b, h) ((4 + (b) * 2 + (h)) * HTB)
#define PG8_STAGE(bufoff, gbase, voff) do { _Pragma("unroll") for (int _i = 0; _i < 2; ++_i) \
        __builtin_amdgcn_global_load_lds((const unsigned*)((const char*)(gbase) + (voff)[_i]), (PG8_LAS unsigned*)(lds + (bufoff) + ldsw + _i * 8192), 16, 0, 0); } while (0)
#define PG8_LDA(dst, b, h) do { _Pragma("unroll") for (int m = 0; m < 4; ++m) _Pragma("unroll") for (int k = 0; k < 2; ++k) dst[m][k] = *(const PG8_LAS bf16x8*)(lds + PG8_SA(b, h) + aoff + m * 2048 + k * 1024); } while (0)
#define PG8_LDB(dst, b, h) do { _Pragma("unroll") for (int n = 0; n < 2; ++n) _Pragma("unroll") for (int k = 0; k < 2; ++k) dst[n][k] = *(const PG8_LAS bf16x8*)(lds + PG8_SB(b, h) + boff + n * 2048 + k * 1024); } while (0)
#define PG8_MMA(ai, bj, At, Bt) do { __builtin_amdgcn_s_setprio(1); _Pragma("unroll") for (int m = 0; m < 4; ++m) _Pragma("unroll") for (int n = 0; n < 2; ++n) _Pragma("unroll") for (int k = 0; k < 2; ++k) \
        acc[ai][bj][m][n] = __builtin_amdgcn_mfma_f32_16x16x32_bf16(Bt[n][k], At[m][k], acc[ai][bj][m][n], 0, 0, 0); __builtin_amdgcn_s_setprio(0); } while (0)
#define PG8_WAIT_V(n) asm volatile("s_waitcnt vmcnt(" #n ")" ::: "memory")
#define PG8_WAIT_L(n) asm volatile("s_waitcnt lgkmcnt(" #n ")" ::: "memory")
#define PG8_BAR __builtin_amdgcn_s_barrier()
#define PG8_SCHED __builtin_amdgcn_sched_barrier(0)
    Unit cur, nxt; int ui = 0;
    if (!S.next(0, cur)) return;
    f32x4 acc[2][2][4][2];
#pragma unroll
    for (int a = 0; a < 2; ++a)
#pragma unroll
        for (int b = 0; b < 2; ++b)
#pragma unroll
            for (int m = 0; m < 4; ++m)
#pragma unroll
                for (int n = 0; n < 2; ++n) acc[a][b][m][n] = (f32x4){0.f, 0.f, 0.f, 0.f};
    bf16x8 At[4][2], B0[2][2], B1[2][2];

    const char* cA = (const char*)g.A + (size_t)cur.pm * tstep; const char* cB = (const char*)g.Bt + (size_t)cur.pn * tstep;
    S.a_ready(cur);

    if constexpr (SP2) {
        PG8_STAGE(PG8_SB(0, 0), cB, voffB); PG8_STAGE(PG8_SB(0, 1), cB + hstep, voffB); PG8_STAGE(PG8_SA(0, 0), cA, voffA); PG8_STAGE(PG8_SA(0, 1), cA + hstep, voffA);
        if (wr == 1) PG8_BAR;
        PG8_WAIT_V(2); PG8_BAR;
        PG8_STAGE(PG8_SB(1, 0), cB + kstep, voffB); PG8_STAGE(PG8_SA(1, 0), cA + kstep, voffA); PG8_STAGE(PG8_SB(1, 1), cB + hstep + kstep, voffB);
        PG8_WAIT_V(6); PG8_BAR;
    } else {
        PG8_STAGE(PG8_SB(0, 0), cB, voffB); PG8_STAGE(PG8_SA(0, 0), cA, voffA); PG8_STAGE(PG8_SB(0, 1), cB + hstep, voffB); PG8_STAGE(PG8_SA(0, 1), cA + hstep, voffA);
        if (wr == 1) PG8_BAR;
        PG8_WAIT_V(4); PG8_BAR;
        PG8_STAGE(PG8_SB(1, 0), cB + kstep, voffB); PG8_STAGE(PG8_SA(1, 0), cA + kstep, voffA); PG8_STAGE(PG8_SB(1, 1), cB + hstep + kstep, voffB);
        PG8_WAIT_V(6); PG8_BAR;
    }
    for (;;) {
        const bool has_next = S.next(ui + 1, nxt);

        const char* nA = has_next ? (const char*)g.A + (size_t)nxt.pm * tstep : cA; const char* nB = has_next ? (const char*)g.Bt + (size_t)nxt.pn * tstep : cB;
        for (int t = 0; t < nt; t += 2) {
            const bool last = (t == nt - 2);
            const char* a1 = cA + (size_t)(t + 1) * kstep;
            const char* a2 = last ? nA : cA + (size_t)(t + 2) * kstep; const char* b2 = last ? nB : cB + (size_t)(t + 2) * kstep;
            const char* a3 = a2 + kstep; const char* b3 = b2 + kstep;
            if (last && has_next) S.a_ready(nxt);
            if constexpr (SP2) {


            PG8_LDB(B0, 0, 0); PG8_LDB(B1, 0, 1); PG8_SCHED; PG8_LDA(At, 0, 0); PG8_STAGE(PG8_SA(1, 1), a1 + hstep, voffA);
            PG8_WAIT_V(8); PG8_WAIT_L(0); PG8_BAR; PG8_MMA(0, 0, At, B0); PG8_MMA(0, 1, At, B1); PG8_BAR; PG8_SCHED;

            PG8_LDA(At, 0, 1); PG8_STAGE(PG8_SB(0, 0), b2, voffB); PG8_STAGE(PG8_SB(0, 1), b2 + hstep, voffB); PG8_STAGE(PG8_SA(0, 0), a2, voffA);
            PG8_WAIT_V(8); PG8_WAIT_L(0); PG8_BAR; PG8_MMA(1, 0, At, B0); PG8_MMA(1, 1, At, B1); PG8_BAR; PG8_SCHED;

            PG8_LDB(B0, 1, 0); PG8_LDB(B1, 1, 1); PG8_SCHED; PG8_LDA(At, 1, 0); PG8_STAGE(PG8_SA(0, 1), a2 + hstep, voffA);
            PG8_WAIT_V(8); PG8_WAIT_L(0); PG8_BAR; PG8_MMA(0, 0, At, B0); PG8_MMA(0, 1, At, B1); PG8_BAR; PG8_SCHED;

            PG8_LDA(At, 1, 1); PG8_STAGE(PG8_SB(1, 0), b3, voffB); PG8_STAGE(PG8_SB(1, 1), b3 + hstep, voffB); PG8_STAGE(PG8_SA(1, 0), a3, voffA);
            PG8_WAIT_V(8); PG8_WAIT_L(0); PG8_BAR; PG8_MMA(1, 0, At, B0); PG8_MMA(1, 1, At, B1); PG8_BAR; PG8_SCHED;
            } else {

            PG8_LDB(B0, 0, 0); PG8_SCHED; PG8_LDA(At, 0, 0); PG8_STAGE(PG8_SA(1, 1), a1 + hstep, voffA);
            PG8_WAIT_L(8); PG8_BAR; PG8_WAIT_L(0); PG8_MMA(0, 0, At, B0); PG8_BAR; PG8_SCHED;

            PG8_LDB(B1, 0, 1); PG8_STAGE(PG8_SB(0, 0), b2, voffB);
            PG8_BAR; PG8_WAIT_L(0); PG8_MMA(0, 1, At, B1); PG8_BAR;

            PG8_LDA(At, 0, 1); PG8_STAGE(PG8_SA(0, 0), a2, voffA);
            PG8_BAR; PG8_WAIT_L(0); PG8_MMA(1, 0, At, B0); PG8_BAR; PG8_SCHED;

            PG8_STAGE(PG8_SB(0, 1), b2 + hstep, voffB);
            PG8_WAIT_V(6); PG8_BAR; PG8_MMA(1, 1, At, B1); PG8_BAR;

            PG8_LDB(B0, 1, 0); PG8_SCHED; PG8_LDA(At, 1, 0); PG8_STAGE(PG8_SA(0, 1), a2 + hstep, voffA);
            PG8_WAIT_L(8); PG8_BAR; PG8_WAIT_L(0); PG8_MMA(0, 0, At, B0); PG8_BAR; PG8_SCHED;

            PG8_LDB(B1, 1, 1); PG8_STAGE(PG8_SB(1, 0), b3, voffB);
            PG8_BAR; PG8_WAIT_L(0); PG8_MMA(0, 1, At, B1); PG8_BAR;

            PG8_LDA(At, 1, 1); PG8_STAGE(PG8_SA(1, 0), a3, voffA);
            PG8_BAR; PG8_WAIT_L(0); PG8_MMA(1, 0, At, B0); PG8_BAR; PG8_SCHED;

            PG8_STAGE(PG8_SB(1, 1), b3 + hstep, voffB);
            PG8_WAIT_V(6); PG8_BAR; PG8_MMA(1, 1, At, B1); PG8_BAR;
            }
        }
        if constexpr (ALIGN_EPI) { if (wr == 0) PG8_BAR; }
        if constexpr (!Epi::AFTER_DRAIN) { E(acc, cur, wr, wc, fr, fq); S.done(cur); }
        if (!has_next) break;
#pragma unroll
        for (int a = 0; a < 2; ++a)
#pragma unroll
            for (int b = 0; b < 2; ++b)
#pragma unroll
                for (int m = 0; m < 4; ++m)
#pragma unroll
                    for (int n = 0; n < 2; ++n) acc[a][b][m][n] = (f32x4){0.f, 0.f, 0.f, 0.f};
        cur = nxt; cA = nA; cB = nB; ++ui;
        if constexpr (ALIGN_EPI) { if (wr == 1) PG8_BAR; }
    }
    PG8_WAIT_V(0);
    if constexpr (!ALIGN_EPI) { if (wr == 0) PG8_BAR; }
    PG8_BAR;
    if constexpr (Epi::AFTER_DRAIN) { E.fused(acc, cur, wr, wc, fr, fq, lds, wid, lane); S.done(cur); }
#undef PG8_SA
#undef PG8_SB
#undef PG8_STAGE
#undef PG8_LDA
#undef PG8_LDB
#undef PG8_MMA
#undef PG8_WAIT_V
#undef PG8_WAIT_L
#undef PG8_BAR
#undef PG8_SCHED
}
}

constexpr size_t WS_WIN = 0;
constexpr size_t WS_WOUT = WS_WIN + (size_t)2 * 5632 * 2048 * 2;
constexpr size_t WS_GLU = WS_WOUT + (size_t)2 * 2048 * 2048 * 2;
constexpr size_t WS_ADA = WS_GLU + (size_t)2 * 512 * 512 * 2;
constexpr size_t WS_EE = WS_ADA + (size_t)2 * 16 * 6144 * 4;
constexpr size_t WS_MF = WS_EE + (size_t)2 * 32 * 256 * 256 * 2;
constexpr size_t WS_A16 = WS_MF + (size_t)2 * 32 * 256 * 512 * 2;
constexpr size_t WS_H = WS_A16 + (size_t)2 * 32 * 2 * 64 * 2 * 4;
constexpr size_t WS_Z = WS_H + (size_t)kT * 2048 * 2;
constexpr size_t WS_AVT = WS_Z + (size_t)kT * kINW * 2;
constexpr size_t WS_RKF = WS_AVT + (size_t)16 * 2 * 128 * 2048 * 2;
constexpr size_t WS_RKB = WS_RKF + (size_t)16 * 4 * 128 * 2048 * 2;
constexpr size_t WS_RVT = WS_RKB + (size_t)16 * 4 * 128 * 2048 * 2;
constexpr size_t WS_UB = WS_RVT + (size_t)16 * 4 * 128 * 2048 * 2;
constexpr size_t WS_YS = WS_UB + (size_t)kT * 512 * 2;
constexpr size_t WS_KVF = WS_YS + (size_t)kT * 512 * 2;
constexpr size_t WS_KVB = WS_KVF + (size_t)16 * 4 * 16 * 16384 * 4;
constexpr size_t WS_SP = WS_KVB + (size_t)16 * 4 * 16 * 16384 * 4;
constexpr size_t WS_SF = WS_SP + (size_t)16 * 4 * 16 * 16384 * 2;
constexpr size_t WS_RA = WS_SF + (size_t)16 * 4 * 16 * 16384 * 2;
constexpr size_t WS_RR = WS_RA + (size_t)kT * 16 * 8;
constexpr size_t WS_CTL = WS_RR + (size_t)kT * 64 * 8;
constexpr size_t CTL_BYTES = 16384;
constexpr size_t WS_END = WS_CTL + CTL_BYTES;
static_assert(WS_END <= (size_t)1073741824, "workspace fits 1 GiB");

struct Params { const float* in[22]; float* out; unsigned char* ws; };

struct EpiZ {
  static constexpr bool PERM = true, AFTER_DRAIN = false;
  bf16_t* Z;
  __device__ __forceinline__ void operator()(const f32x4 (&acc)[2][2][4][2], const pg8::Unit& u, int wr, int wc, int fr, int fq) const {
    const int pn = u.pn;
    const bool gate = (pn == 2 || pn == 3 || (pn >= 10 && pn <= 13) || pn >= 20);
    const int row0 = u.pm * 256 + wr * 64 + fr, col0 = pn * 256 + wc * 32 + 8 * fq;
#pragma unroll
    for (int ai = 0; ai < 2; ++ai)
#pragma unroll
      for (int m = 0; m < 4; ++m) {
        bf16_t* rowp = Z + (size_t)(row0 + ai * 128 + m * 16) * kINW + col0;
#pragma unroll
        for (int bj = 0; bj < 2; ++bj) {
          f32x4 v0 = acc[ai][bj][m][0], v1 = acc[ai][bj][m][1];
          if (gate) {
#pragma unroll
            for (int j = 0; j < 4; ++j) { v0[j] = silu_f(v0[j]); v1[j] = silu_f(v1[j]); }
          }
          u32x4 w; w.x = pk2(v0[0], v0[1]); w.y = pk2(v0[2], v0[3]); w.z = pk2(v1[0], v1[1]); w.w = pk2(v1[2], v1[3]);
          *(u32x4*)(rowp + bj * 128) = w;
        }
      }
  }
};
struct EpiGlu {
  static constexpr bool PERM = true, AFTER_DRAIN = false;
  const bf16_t* YS; const bf16_t* Z; const float* bias; bf16_t* YC;
  __device__ __forceinline__ void operator()(const f32x4 (&acc)[2][2][4][2], const pg8::Unit& u, int wr, int wc, int fr, int fq) const {
    const int row0 = u.pm * 256 + wr * 64 + fr, col0 = u.pn * 256 + wc * 32 + 8 * fq;
    f32x4 bv[2][2];
#pragma unroll
    for (int bj = 0; bj < 2; ++bj) { bv[bj][0] = *(const f32x4*)(bias + col0 + bj * 128); bv[bj][1] = *(const f32x4*)(bias + col0 + bj * 128 + 4); }
#pragma unroll
    for (int ai = 0; ai < 2; ++ai)
#pragma unroll
      for (int mp = 0; mp < 2; ++mp) {
        u32x4 yv[2][2], gv[2][2];
#pragma unroll
        for (int mm = 0; mm < 2; ++mm)
#pragma unroll
          for (int bj = 0; bj < 2; ++bj) {
            const size_t row = (size_t)(row0 + ai * 128 + (mp * 2 + mm) * 16); const int col = col0 + bj * 128;
            yv[mm][bj] = *(const u32x4*)(YS + row * 512 + col); gv[mm][bj] = *(const u32x4*)(Z + row * kINW + ZC_SG + col);
          }
#pragma unroll
        for (int mm = 0; mm < 2; ++mm)
#pragma unroll
          for (int bj = 0; bj < 2; ++bj) {
            const int m = mp * 2 + mm;
            const size_t row = (size_t)(row0 + ai * 128 + m * 16); const int col = col0 + bj * 128;
            const f32x4 a0 = acc[ai][bj][m][0] + bv[bj][0], a1 = acc[ai][bj][m][1] + bv[bj][1];
            const u32x4 y4 = yv[mm][bj], g4 = gv[mm][bj];
            u32x4 w;
            w.x = pk2(bflo(y4.x) * sigmoid_f(a0[0]) * bflo(g4.x), bfhi(y4.x) * sigmoid_f(a0[1]) * bfhi(g4.x));
            w.y = pk2(bflo(y4.y) * sigmoid_f(a0[2]) * bflo(g4.y), bfhi(y4.y) * sigmoid_f(a0[3]) * bfhi(g4.y));
            w.z = pk2(bflo(y4.z) * sigmoid_f(a1[0]) * bflo(g4.z), bfhi(y4.z) * sigmoid_f(a1[1]) * bfhi(g4.z));
            w.w = pk2(bflo(y4.w) * sigmoid_f(a1[2]) * bflo(g4.w), bfhi(y4.w) * sigmoid_f(a1[3]) * bfhi(g4.w));
            *(u32x4*)(YC + row * 2048 + col) = w;
          }
      }
  }
};
struct EpiOut {
  static constexpr bool PERM = false, AFTER_DRAIN = false;
  const float* Xin; float* Xout; const float* gate;
  __device__ __forceinline__ void operator()(const f32x4 (&acc)[2][2][4][2], const pg8::Unit& u, int wr, int wc, int fr, int fq) const {
    const int row0 = u.pm * 256 + wr * 64 + fr, col0 = u.pn * 256 + wc * 32 + 4 * fq;
    const float* gp = gate + (size_t)(u.pm >> 3) * 6144 + col0;
    f32x4 gv[2][2];
#pragma unroll
    for (int bj = 0; bj < 2; ++bj)
#pragma unroll
      for (int n = 0; n < 2; ++n) gv[bj][n] = *(const f32x4*)(gp + bj * 128 + n * 16);
#pragma unroll
    for (int ai = 0; ai < 2; ++ai)
#pragma unroll
      for (int mp = 0; mp < 2; ++mp) {
        f32x4 xv[2][2][2];
#pragma unroll
        for (int mm = 0; mm < 2; ++mm)
#pragma unroll
          for (int bj = 0; bj < 2; ++bj)
#pragma unroll
            for (int n = 0; n < 2; ++n) xv[mm][bj][n] = *(const f32x4*)(Xin + (size_t)(row0 + ai * 128 + (mp * 2 + mm) * 16) * 2048 + col0 + bj * 128 + n * 16);
#pragma unroll
        for (int mm = 0; mm < 2; ++mm)
#pragma unroll
          for (int bj = 0; bj < 2; ++bj)
#pragma unroll
            for (int n = 0; n < 2; ++n)
              *(f32x4*)(Xout + (size_t)(row0 + ai * 128 + (mp * 2 + mm) * 16) * 2048 + col0 + bj * 128 + n * 16) = xv[mm][bj][n] + gv[bj][n] * acc[ai][bj][mp * 2 + mm][n];
      }
  }
};

__device__ __forceinline__ float lgam2(int h) { return log1pf(-exp2f(-5.0f - (float)h)) * 1.4426950408889634f; }

struct TrUnit { const float* src; bf16_t* dst; int N, K; };
__device__ __forceinline__ TrUnit tr_decode(const Params& p, int u) {
  const int l = u / 3904, r = u % 3904; TrUnit t;
  if (r < 2816) { const int tk = r / 88, tn = r % 88; t.N = 5632; t.K = 2048; t.src = p.in[6] + (size_t)l * 2048 * 5632 + (size_t)tk * 64 * 5632 + tn * 64; t.dst = (bf16_t*)(p.ws + WS_WIN) + (size_t)l * 5632 * 2048 + (size_t)tn * 64 * 2048 + tk * 64; }
  else if (r < 3840) { const int q = r - 2816, tk = q >> 5, tn = q & 31; t.N = 2048; t.K = 2048; t.src = p.in[7] + (size_t)l * 2048 * 2048 + (size_t)tk * 64 * 2048 + tn * 64; t.dst = (bf16_t*)(p.ws + WS_WOUT) + (size_t)l * 2048 * 2048 + (size_t)tn * 64 * 2048 + tk * 64; }
  else { const int q = r - 3840, tk = q >> 3, tn = q & 7; t.N = 512; t.K = 512; t.src = p.in[16] + (size_t)l * 512 * 512 + (size_t)tk * 64 * 512 + tn * 64; t.dst = (bf16_t*)(p.ws + WS_GLU) + (size_t)l * 512 * 512 + (size_t)tn * 64 * 512 + tk * 64; }
  return t;
}
__device__ __forceinline__ void tr_load(const Params& p, int u, int tid, f32x4 (&v)[2]) {
  if (u < 7808) { const TrUnit t = tr_decode(p, u);
#pragma unroll
    for (int i = 0; i < 2; ++i) { const int idx = tid + i * 512, r = idx >> 4, c4 = idx & 15; v[i] = *(const f32x4*)(t.src + (size_t)r * t.N + c4 * 4); } }
}
__device__ __forceinline__ void tr_store(const Params& p, int u, int tid, const f32x4 (&v)[2], LAS float* scr) {
  if (u < 7808) {
    const TrUnit t = tr_decode(p, u);
    __syncthreads();
#pragma unroll
    for (int i = 0; i < 2; ++i) { const int idx = tid + i * 512, r = idx >> 4, c4 = idx & 15; LAS float* d = scr + r * 65 + c4 * 4; d[0] = v[i][0]; d[1] = v[i][1]; d[2] = v[i][2]; d[3] = v[i][3]; }
    __syncthreads();
    const int n = tid >> 3, kc = tid & 7;
    float f[8];
#pragma unroll
    for (int j = 0; j < 8; ++j) f[j] = scr[(kc * 8 + j) * 65 + n];
    u32x4 w; w.x = pk2(f[0], f[1]); w.y = pk2(f[2], f[3]); w.z = pk2(f[4], f[5]); w.w = pk2(f[6], f[7]);
    *(u32x4*)(t.dst + (size_t)n * t.K + kc * 8) = w;
  }
}

__device__ __forceinline__ void ada_unit(const Params& p, int u, LAS unsigned char* lds, int tid) {
  const int l = u / 96, cgp = u % 96, lane = tid & 63, wave = tid >> 6;
  const int kq = lane >> 4, c4 = lane & 15;
  LAS float* cact = (LAS float*)lds;
  const float* c = p.in[1];
  __syncthreads();
  for (int i = tid; i < 8192; i += 512) {
    const int k = i & 2047, bq = i >> 11;
    f32x4 v; v[0] = silu_f(c[(4 * bq) * 2048 + k]); v[1] = silu_f(c[(4 * bq + 1) * 2048 + k]); v[2] = silu_f(c[(4 * bq + 2) * 2048 + k]); v[3] = silu_f(c[(4 * bq + 3) * 2048 + k]);
    *(LAS f32x4*)(cact + k * 16 + 4 * bq) = v;
  }
  __syncthreads();
  const float* W = p.in[4] + (size_t)l * 2048 * 6144 + cgp * 64 + 4 * c4;
  f32x4 acc[16];
#pragma unroll
  for (int b = 0; b < 16; ++b) acc[b] = (f32x4){0.f, 0.f, 0.f, 0.f};
  for (int i0 = 0; i0 < 64; i0 += 16) {
    f32x4 wv[16];
#pragma unroll
    for (int ii = 0; ii < 16; ++ii) wv[ii] = *(const f32x4*)(W + (size_t)(wave * 256 + 4 * (i0 + ii) + kq) * 6144);
#pragma unroll
    for (int ii = 0; ii < 16; ++ii) {
      const int k = wave * 256 + 4 * (i0 + ii) + kq;
      const f32x4 c0 = *(LAS f32x4*)(cact + k * 16), c1 = *(LAS f32x4*)(cact + k * 16 + 4), c2 = *(LAS f32x4*)(cact + k * 16 + 8), c3 = *(LAS f32x4*)(cact + k * 16 + 12);
#pragma unroll
      for (int j = 0; j < 4; ++j) { acc[j] += wv[ii] * c0[j]; acc[4 + j] += wv[ii] * c1[j]; acc[8 + j] += wv[ii] * c2[j]; acc[12 + j] += wv[ii] * c3[j]; }
    }
  }
#pragma unroll
  for (int b = 0; b < 16; ++b)
#pragma unroll
    for (int j = 0; j < 4; ++j) { float v = acc[b][j]; v += __shfl_xor(v, 16); v += __shfl_xor(v, 32); acc[b][j] = v; }
  __syncthreads();
  LAS float* red = (LAS float*)lds;
  if (kq == 0) {
#pragma unroll
    for (int b = 0; b < 16; ++b) *(LAS f32x4*)(red + (wave * 16 + b) * 64 + 4 * c4) = acc[b];
  }
  __syncthreads();
  float* ada = (float*)(p.ws + WS_ADA);
#pragma unroll
  for (int i = 0; i < 2; ++i) {
    const int o = tid + i * 512, b = o >> 6, nn = o & 63;
    float s = 0.f;
#pragma unroll
    for (int w = 0; w < 8; ++w) s += red[(w * 16 + b) * 64 + nn];
    ada[(size_t)(l * 16 + b) * 6144 + cgp * 64 + nn] = s + p.in[5][l * 6144 + cgp * 64 + nn];
  }
  __syncthreads();
}

__device__ __forceinline__ void s5mat_unit(const Params& p, int u, LAS unsigned char* lds, int tid) {
  const int l = u >> 5, g = u & 31;
  LAS float* pwre = (LAS float*)lds;
  LAS float* pwim = pwre + 2176;
  LAS float* bbre = pwim + 2176;
  LAS float* bbim = bbre + 2048;
  LAS float* cre = bbim + 2048;
  LAS float* cim = cre + 2048;
  LAS float* Kf = cim + 2048;
  LAS float* Kb = Kf + 4096;
  __syncthreads();
  if (tid < 128) {
    const int dir = tid >> 6, n = tid & 63;
    const int ig = (l * 2 + dir) * 32 + g;
    const float dt = expf(p.in[10][ig]);
    const float lr = p.in[8][ig * 64 + n], li = p.in[9][ig * 64 + n];
    for (int k = 0; k <= 16; ++k) {
      const float mag = expf(lr * dt * (float)k); float s, c; sincosf(li * dt * (float)k, &s, &c);
      pwre[(dir * 17 + k) * 64 + n] = mag * c; pwim[(dir * 17 + k) * 64 + n] = mag * s;
    }
    const float mag = expf(lr * dt); float s1, c1; sincosf(li * dt, &s1, &c1);
    const float abr = mag * c1, abi = mag * s1, nr = abr - 1.0f, den = lr * lr + li * li;
    const float fre = (nr * lr + abi * li) / den, fim = (abi * lr - nr * li) / den;
    for (int q = 0; q < 16; ++q) {
      const float br = p.in[11][((size_t)ig * 64 + n) * 16 + q], bi = p.in[12][((size_t)ig * 64 + n) * 16 + q];
      bbre[(dir * 64 + n) * 16 + q] = fre * br - fim * bi; bbim[(dir * 64 + n) * 16 + q] = fre * bi + fim * br;
    }
    float* a16 = (float*)(p.ws + WS_A16) + ((size_t)((l * 32 + g) * 2 + dir) * 64 + n) * 2;
    const float m16 = expf(lr * dt * 16.0f); float s16, c16; sincosf(li * dt * 16.0f, &s16, &c16);
    a16[0] = m16 * c16; a16[1] = m16 * s16;
  }
  for (int i = tid; i < 2048; i += 512) {
    const int dir = i >> 10, r = i & 1023;
    const size_t gi = ((size_t)((l * 2 + dir) * 32 + g)) * 1024 + r;
    cre[i] = p.in[13][gi]; cim[i] = p.in[14][gi];
  }
  __syncthreads();
  {
    const int dir = tid >> 8, tau = (tid >> 4) & 15, pp = tid & 15;
    float sq[16];
#pragma unroll
    for (int q = 0; q < 16; ++q) sq[q] = 0.f;
    for (int n = 0; n < 64; ++n) {
      const float cr = cre[(dir * 16 + pp) * 64 + n], ci = cim[(dir * 16 + pp) * 64 + n];
      const float pr = pwre[(dir * 17 + tau) * 64 + n], pi = pwim[(dir * 17 + tau) * 64 + n];
      const float xr = cr * pr - ci * pi, xi = cr * pi + ci * pr;
      const LAS f32x4* br4 = (const LAS f32x4*)(bbre + (dir * 64 + n) * 16);
      const LAS f32x4* bi4 = (const LAS f32x4*)(bbim + (dir * 64 + n) * 16);
#pragma unroll
      for (int q4 = 0; q4 < 4; ++q4) { const f32x4 br = br4[q4], bi = bi4[q4];
#pragma unroll
        for (int j = 0; j < 4; ++j) sq[q4 * 4 + j] += xr * br[j] - xi * bi[j]; }
    }
#pragma unroll
    for (int q = 0; q < 16; ++q) (dir ? Kb : Kf)[tau * 256 + pp * 16 + q] = sq[q];
  }
  __syncthreads();
  bf16_t* EE = (bf16_t*)(p.ws + WS_EE) + (size_t)(l * 32 + g) * 256 * 256;
  for (int ch = tid; ch < 8192; ch += 512) {
    const int row = ch >> 5, c8 = (ch & 31) * 8, j = c8 >> 4, q0 = c8 & 15;
    const int dir = row >> 7, part = (row >> 6) & 1, n = row & 63;
    const int kp = dir ? j : 15 - j;
    const float pr = pwre[(dir * 17 + kp) * 64 + n], pi = pwim[(dir * 17 + kp) * 64 + n];
    float f[8];
#pragma unroll
    for (int e = 0; e < 8; ++e) {
      const float br = bbre[(dir * 64 + n) * 16 + q0 + e], bi = bbim[(dir * 64 + n) * 16 + q0 + e];
      f[e] = part ? (pr * bi + pi * br) : (pr * br - pi * bi);
    }
    u32x4 w; w.x = pk2(f[0], f[1]); w.y = pk2(f[2], f[3]); w.z = pk2(f[4], f[5]); w.w = pk2(f[6], f[7]);
    *(u32x4*)(EE + (size_t)row * 256 + c8) = w;
  }
  bf16_t* MF = (bf16_t*)(p.ws + WS_MF) + (size_t)(l * 32 + g) * 256 * 512;
  for (int ch = tid; ch < 16384; ch += 512) {
    const int row = ch >> 6, c8 = (ch & 63) * 8, i = row >> 4, pp = row & 15;
    float f[8];
    if (c8 < 256) {
      const int j = c8 >> 4, q0 = c8 & 15;
#pragma unroll
      for (int e = 0; e < 8; ++e) {
        const int q = q0 + e; float v = 0.f;
        if (i >= j) v += Kf[(i - j) * 256 + pp * 16 + q];
        if (j >= i) v += Kb[(j - i) * 256 + pp * 16 + q];
        if (i == j && pp == q) v += p.in[15][l * 512 + g * 16 + pp];
        f[e] = v;
      }
    } else {
#pragma unroll
      for (int e = 0; e < 8; ++e) {
        const int cc = c8 - 256 + e, dir = cc >> 7, part = (cc >> 6) & 1, n = cc & 63;
        const int kp = dir ? 16 - i : i + 1;
        const float cr = cre[(dir * 16 + pp) * 64 + n], ci = cim[(dir * 16 + pp) * 64 + n];
        const float pr = pwre[(dir * 17 + kp) * 64 + n], pi = pwim[(dir * 17 + kp) * 64 + n];
        f[e] = part ? -(cr * pi + ci * pr) : (cr * pr - ci * pi);
      }
    }
    u32x4 w; w.x = pk2(f[0], f[1]); w.y = pk2(f[2], f[3]); w.z = pk2(f[4], f[5]); w.w = pk2(f[6], f[7]);
    *(u32x4*)(MF + (size_t)row * 512 + c8) = w;
  }
  __syncthreads();
}

__device__ __forceinline__ void phase0(const Params& p, LAS unsigned char* lds, int tid, int G) {
  for (int su = blockIdx.x; su < 256; su += G) { if (su < 192) ada_unit(p, su, lds, tid); else s5mat_unit(p, su - 192, lds, tid); }
  {
    float* ropeA = (float*)(p.ws + WS_RA); float* ropeR = (float*)(p.ws + WS_RR);
    const int* pos = (const int*)p.in[2];
  }
  LAS float* scr = (LAS float*)lds;
  {
    f32x4 tb[4][2];
    const bool split = (G == 256);
    const int bx = blockIdx.x, nmine = split ? (bx < 192 ? 33 : 23) : (7808 - bx + G - 1) / G;
#define TR_UNIT(J) ((J) < nmine ? (split ? (bx < 192 ? (J) * 192 + bx : 6336 + (J) * 64 + (bx - 192)) : bx + (J) * G) : 7808)
    tr_load(p, TR_UNIT(0), tid, tb[0]); tr_load(p, TR_UNIT(1), tid, tb[1]); tr_load(p, TR_UNIT(2), tid, tb[2]);
    for (int jb = 0; jb < nmine; jb += 4) {
#pragma unroll
      for (int j = 0; j < 4; ++j) {
        tr_load(p, TR_UNIT(jb + j + 3), tid, tb[(j + 3) & 3]);
        tr_store(p, TR_UNIT(jb + j), tid, tb[j], scr);
      }
    }
#undef TR_UNIT
  }
}

__device__ __forceinline__ void norm_phase(const Params& p, int l, const float* xin, LAS unsigned char* lds, int tid, int G) {
  const int lane = tid & 63, wave = tid >> 6;
  bf16_t* H = (bf16_t*)(p.ws + WS_H);
  const float* ada = (const float*)(p.ws + WS_ADA) + (size_t)l * 16 * 6144;
  const float* nw = p.in[3] + l * 2048;
  const int* pos = (const int*)p.in[2];
  float* ropeA = (float*)(p.ws + WS_RA); float* ropeR = (float*)(p.ws + WS_RR);
  const float invr = powf(10000.0f, -(float)lane * (2.0f / 128.0f)), inva = powf(500000.0f, -(float)(lane & 15) * (2.0f / 32.0f));
  const int rpb = kT / G;
  const int row0 = blockIdx.x * rpb, b = row0 >> 11;
  LAS float* csl = (LAS float*)lds;
  LAS float* shl = csl + 2048;
  __syncthreads();
  for (int k = tid; k < 2048; k += 512) { csl[k] = nw[k] * (1.0f + ada[(size_t)b * 6144 + 2048 + k]); shl[k] = ada[(size_t)b * 6144 + k]; }
  __syncthreads();
  f32x4 v[8], vn[8];
  int row = row0 + wave;
  const int rend = row0 + rpb;
#pragma unroll
  for (int i = 0; i < 8; ++i) v[i] = __builtin_nontemporal_load((const f32x4*)(xin + (size_t)row * 2048 + (i * 64 + lane) * 4));
  for (; row < rend; row += 8) {
    const int nrow = row + 8;
    if (nrow < rend) {
#pragma unroll
      for (int i = 0; i < 8; ++i) vn[i] = __builtin_nontemporal_load((const f32x4*)(xin + (size_t)nrow * 2048 + (i * 64 + lane) * 4));
    }
    if (l == 0) {
      const float fpos = (float)pos[row];
      float sv, cv; sincosf(fpos * invr, &sv, &cv);
      f32x2 o; o.x = cv; o.y = sv; *(f32x2*)(ropeR + ((size_t)row * 64 + lane) * 2) = o;
      float sa, ca; sincosf(fpos * inva, &sa, &ca);
      if (lane < 16) { f32x2 oa; oa.x = ca; oa.y = sa; *(f32x2*)(ropeA + ((size_t)row * 16 + lane) * 2) = oa; }
    }
    float ss = 0.f;
#pragma unroll
    for (int i = 0; i < 8; ++i) ss += v[i][0] * v[i][0] + v[i][1] * v[i][1] + v[i][2] * v[i][2] + v[i][3] * v[i][3];
    ss = wave_sum(ss);
    const float rstd = rsqrtf(ss * (1.0f / 2048.0f) + 1e-6f);
    u32x2 ow[8];
#pragma unroll
    for (int i = 0; i < 8; ++i) {
      const int col = (i * 64 + lane) * 4;
      const f32x4 c4 = *(const LAS f32x4*)(csl + col), s4 = *(const LAS f32x4*)(shl + col);
      const f32x4 y = v[i] * rstd * c4 + s4;
      ow[i].x = pk2(y[0], y[1]); ow[i].y = pk2(y[2], y[3]);
    }
#pragma unroll
    for (int i = 0; i < 8; ++i) *(u32x2*)(H + (size_t)row * 2048 + (i * 64 + lane) * 4) = ow[i];
#pragma unroll
    for (int i = 0; i < 8; ++i) v[i] = vn[i];
  }
  __syncthreads();
}

__device__ __forceinline__ void unpack8(const u32x4 v, float (&f)[8]) { f[0] = bflo(v.x); f[1] = bfhi(v.x); f[2] = bflo(v.y); f[3] = bfhi(v.y); f[4] = bflo(v.z); f[5] = bfhi(v.z); f[6] = bflo(v.w); f[7] = bfhi(v.w); }
__device__ __forceinline__ u32x4 pack8(const float (&f)[8]) { u32x4 w; w.x = pk2(f[0], f[1]); w.y = pk2(f[2], f[3]); w.z = pk2(f[4], f[5]); w.w = pk2(f[6], f[7]); return w; }
__device__ __forceinline__ void prep_phase(const Params& p, int l, LAS unsigned char* lds, int tid, int G) {
  bf16_t* Z = (bf16_t*)(p.ws + WS_Z);
  bf16_t* AVT = (bf16_t*)(p.ws + WS_AVT);
  bf16_t* RKF = (bf16_t*)(p.ws + WS_RKF);
  bf16_t* RKB = (bf16_t*)(p.ws + WS_RKB);
  bf16_t* RVT = (bf16_t*)(p.ws + WS_RVT);
  const float* ropeA = (const float*)(p.ws + WS_RA);
  const float* ropeR = (const float*)(p.ws + WS_RR);
  const float* qn = p.in[18] + l * 128; const float* kn = p.in[19] + l * 128;
  const int c = tid & 15, rsub = tid >> 4;
  const float qs = 0.08838834764831845f;
  LAS bf16_t* tile = (LAS bf16_t*)lds;
  for (int unit = blockIdx.x; unit < 512; unit += G) {
    const int tok0 = unit * 64, b = tok0 >> 11;
    for (int kind = 1; kind < 2; ++kind) {
      float wn[8], wqf[8];
      { const f32x4 a = *(const f32x4*)(qn + 8 * c), bq = *(const f32x4*)(qn + 8 * c + 4);
        wqf[0] = a[0]; wqf[1] = a[1]; wqf[2] = a[2]; wqf[3] = a[3]; wqf[4] = bq[0]; wqf[5] = bq[1]; wqf[6] = bq[2]; wqf[7] = bq[3]; }
      { const f32x4 a = *(const f32x4*)((kind ? kn : qn) + 8 * c), bq = *(const f32x4*)((kind ? kn : qn) + 8 * c + 4);
        wn[0] = a[0]; wn[1] = a[1]; wn[2] = a[2]; wn[3] = a[3]; wn[4] = bq[0]; wn[5] = bq[1]; wn[6] = bq[2]; wn[7] = bq[3]; }
      const int nit = kind ? 4 : 16;
      for (int it0 = 0; it0 < nit; it0 += 4) {
        u32x4 vv[4]; f32x4 rr[4][4];
#pragma unroll
        for (int q = 0; q < 4; ++q) {
          const int R = (it0 + q) * 32 + rsub, hh = R >> 6, ts = R & 63, tok = tok0 + ts;
          vv[q] = *(const u32x4*)(Z + (size_t)tok * kINW + (kind ? ZC_AK : ZC_AQ) + hh * 128 + 8 * c);
          const float* rp = ropeA + ((size_t)tok * 16 + 8 * (c & 1)) * 2;
          rr[q][0] = *(const f32x4*)rp; rr[q][1] = *(const f32x4*)(rp + 4); rr[q][2] = *(const f32x4*)(rp + 8); rr[q][3] = *(const f32x4*)(rp + 12);
        }
#pragma unroll
        for (int q = 0; q < 4; ++q) {
          const int R = (it0 + q) * 32 + rsub, hh = R >> 6, ts = R & 63, tok = tok0 + ts;
          float f[8]; unpack8(vv[q], f);
          float ss = 0.f;
#pragma unroll
          for (int j = 0; j < 8; ++j) ss += f[j] * f[j];
          ss += __shfl_xor(ss, 1); ss += __shfl_xor(ss, 2); ss += __shfl_xor(ss, 4); ss += __shfl_xor(ss, 8);
          const float rstd = rsqrtf(ss * (1.0f / 128.0f) + 1e-6f);
          const f32x4 r0 = rr[q][0], r1 = rr[q][1], r2 = rr[q][2], r3 = rr[q][3];
          const float cs[8] = {r0[0], r0[2], r1[0], r1[2], r2[0], r2[2], r3[0], r3[2]};
          const float sn[8] = {r0[1], r0[3], r1[1], r1[3], r2[1], r2[3], r3[1], r3[3]};
          const float sgn = (c & 2) ? 1.0f : -1.0f;
#pragma unroll
          for (int j = 0; j < 8; ++j) {
            const float y = f[j] * rstd * wn[j];
            const float pr = __shfl_xor(y, 2);
            f[j] = (c < 4) ? (y * cs[j] + sgn * pr * sn[j]) : y * wqf[j];
          }
          *(u32x4*)(Z + (size_t)tok * kINW + (kind ? ZC_AK : ZC_AQ) + hh * 128 + 8 * c) = pack8(f);
        }
      }
    }
    for (int it0 = 0; it0 < 16; it0 += 4) {
      u32x4 vv[4]; f32x4 rr[4][4];
#pragma unroll
      for (int q = 0; q < 4; ++q) {
        const int R = (it0 + q) * 32 + rsub, hh = R >> 6, ts = R & 63, tok = tok0 + ts;
        vv[q] = *(const u32x4*)(Z + (size_t)tok * kINW + (hh < 4 ? ZC_RQ + hh * 128 : ZC_RK + (hh - 4) * 128) + 8 * c);
        const float* rp = ropeR + ((size_t)tok * 64 + 8 * (c & 7)) * 2;
        rr[q][0] = *(const f32x4*)rp; rr[q][1] = *(const f32x4*)(rp + 4); rr[q][2] = *(const f32x4*)(rp + 8); rr[q][3] = *(const f32x4*)(rp + 12);
      }
#pragma unroll
      for (int q = 0; q < 4; ++q) {
        const int R = (it0 + q) * 32 + rsub, hh = R >> 6, ts = R & 63, tok = tok0 + ts;
        float f[8]; unpack8(vv[q], f);
        const f32x4 r0 = rr[q][0], r1 = rr[q][1], r2 = rr[q][2], r3 = rr[q][3];
        const float cs[8] = {r0[0], r0[2], r1[0], r1[2], r2[0], r2[2], r3[0], r3[2]};
        const float sn[8] = {r0[1], r0[3], r1[1], r1[3], r2[1], r2[3], r3[1], r3[3]};
        const float sgn = (c & 8) ? 1.0f : -1.0f;
#pragma unroll
        for (int j = 0; j < 8; ++j) { const float pr = __shfl_xor(f[j], 8); f[j] = (f[j] * cs[j] + sgn * pr * sn[j]) * qs; }
        const u32x4 o = pack8(f);
        *(u32x4*)(Z + (size_t)tok * kINW + (hh < 4 ? ZC_RQ + hh * 128 : ZC_RK + (hh - 4) * 128) + 8 * c) = o;
      }
    }
  }
}

__device__ __forceinline__ void attn_phase(const Params& p, int l, LAS unsigned char* lds, int tid, int G) {
  const int lane = tid & 63, wave = tid >> 6, l31 = lane & 31, hh = lane >> 5;
  const bf16_t* Z = (const bf16_t*)(p.ws + WS_Z);
  const bf16_t* AVT = (const bf16_t*)(p.ws + WS_AVT);
  bf16_t* YC = (bf16_t*)(p.ws + WS_H);
  const float* qn = p.in[18] + l * 128; const float* kn = p.in[19] + l * 128; const float* sink = p.in[20] + l * 8;
  const float mq = wave_max(fmaxf(fabsf(qn[lane]), fabsf(qn[lane + 64]))), mk = wave_max(fmaxf(fabsf(kn[lane]), fabsf(kn[lane + 64])));
  const float smax = 11.313708499f * mq * mk * 1.01f + 0.1f;
  LAS unsigned char* Pw = lds + 69632 + wave * 4608;
  LAS float* Dn = (LAS float*)(lds + 69632 + 8 * 4608 + wave * 128);
  __syncthreads();
  const int vcu = (G % 8 == 0) ? ((int)blockIdx.x % 8) * (G / 8) + (int)blockIdx.x / 8 : (int)blockIdx.x;
  const int upb = (1024 + G - 1) / G;
  for (int ui = 0; ui < upb; ++ui) {
    const int unit = vcu * upb + ui;
    if (unit >= 1024) break;
    const int qb = unit & 31, kvh = (unit >> 5) & 1, b = unit >> 6;
    const int hq = kvh * 4 + (wave >> 1), q0 = qb * 64 + (wave & 1) * 32;
    const float sk = sink[hq] * 1.4426950408889634f, shift = fmaxf(smax * 1.4426950408889634f, sk);
    const bf16_t* qrow = Z + (size_t)(b * 2048 + q0 + l31) * kINW + ZC_AQ + hq * 128 + 8 * hh;
    bf16x8 Qf[8];
#pragma unroll
    for (int ks = 0; ks < 8; ++ks) Qf[ks] = ldg8(qrow + 16 * ks);
    {
      const float* rp = (const float*)(p.ws + WS_RA) + ((size_t)(b * 2048 + q0 + l31) * 16 + 8 * hh) * 2;
      const f32x4 r0 = *(const f32x4*)rp, r1 = *(const f32x4*)(rp + 4), r2 = *(const f32x4*)(rp + 8), r3 = *(const f32x4*)(rp + 12);
      const f32x4 wl0 = *(const f32x4*)(qn + 8 * hh), wl1 = *(const f32x4*)(qn + 8 * hh + 4), wh0 = *(const f32x4*)(qn + 16 + 8 * hh), wh1 = *(const f32x4*)(qn + 16 + 8 * hh + 4);
      float ssq = 0.f;
#pragma unroll
      for (int ks = 0; ks < 8; ++ks) { float f[8]; unpack8(__builtin_bit_cast(u32x4, Qf[ks]), f);
#pragma unroll
        for (int j = 0; j < 8; ++j) ssq += f[j] * f[j]; }
      ssq += __shfl_xor(ssq, 32);
      const float sc = rsqrtf(ssq * (1.0f / 128.0f) + 1e-6f) * (0.08838834764831845f * 1.4426950408889634f);
#pragma unroll
      for (int ks = 2; ks < 8; ++ks) { float f[8]; unpack8(__builtin_bit_cast(u32x4, Qf[ks]), f);
#pragma unroll
        for (int j = 0; j < 8; ++j) f[j] *= sc;
        Qf[ks] = __builtin_bit_cast(bf16x8, pack8(f)); }
      float x1[8], x2[8]; unpack8(__builtin_bit_cast(u32x4, Qf[0]), x1); unpack8(__builtin_bit_cast(u32x4, Qf[1]), x2);
      const float cs[8] = {r0[0], r0[2], r1[0], r1[2], r2[0], r2[2], r3[0], r3[2]};
      const float sn[8] = {r0[1], r0[3], r1[1], r1[3], r2[1], r2[3], r3[1], r3[3]};
      const float wl[8] = {wl0[0], wl0[1], wl0[2], wl0[3], wl1[0], wl1[1], wl1[2], wl1[3]};
      const float wh[8] = {wh0[0], wh0[1], wh0[2], wh0[3], wh1[0], wh1[1], wh1[2], wh1[3]};
#pragma unroll
      for (int j = 0; j < 8; ++j) { const float a = x1[j] * sc * wl[j], bq = x2[j] * sc * wh[j]; x1[j] = a * cs[j] - bq * sn[j]; x2[j] = bq * cs[j] + a * sn[j]; }
      Qf[0] = __builtin_bit_cast(bf16x8, pack8(x1)); Qf[1] = __builtin_bit_cast(bf16x8, pack8(x2));
    }
    f32x16 O[4];
#pragma unroll
    for (int nt = 0; nt < 4; ++nt) O[nt] = zero16();
    float lsum = 0.f;
    const int qpos = q0 + l31;
    const int kt_lo = qb >= 2 ? 0 : 2 - qb, kt_hi = (33 - qb) < 4 ? (33 - qb) : 4;
    const int kr_ = tid >> 4, kc8 = (tid & 15) * 8;
    const bf16_t* kgp = Z + (long)(b * 2048 + qb * 64 - 128 + kr_) * (long)kINW + ZC_AK + kvh * 128 + kc8;
    const bf16_t* vgp = kgp + (ZC_AV - ZC_AK);
    u32x4 kreg[2], vreg[2];
#pragma unroll
    for (int i = 0; i < 2; ++i) { kreg[i] = *(const u32x4*)(kgp + (long)(kt_lo * 64 + i * 32) * (long)kINW); vreg[i] = *(const u32x4*)(vgp + (long)(kt_lo * 64 + i * 32) * (long)kINW); }
#pragma unroll
    for (int i = 0; i < 2; ++i) { *(LAS u32x4*)(lds + ((kr_ + i * 32) * 136 + kc8) * 2) = kreg[i]; *(LAS u32x4*)(lds + 17408 + ((kr_ + i * 32) * 136 + kc8) * 2) = vreg[i]; }
    if (kt_lo < kt_hi) {
#pragma unroll
      for (int i = 0; i < 2; ++i) { kreg[i] = *(const u32x4*)(kgp + (long)((kt_lo + 1) * 64 + i * 32) * (long)kINW); vreg[i] = *(const u32x4*)(vgp + (long)((kt_lo + 1) * 64 + i * 32) * (long)kINW); }
    }
    __syncthreads();
    for (int kt = kt_lo; kt <= kt_hi; ++kt) {
      const int key0 = qb * 64 - 128 + kt * 64;
      LAS unsigned char* Ks = lds + ((kt - kt_lo) & 1) * 34816;
      LAS unsigned char* Vs = Ks + 17408;
      f32x16 St[2]; St[0] = zero16(); St[1] = zero16();
#pragma unroll
      for (int ks = 0; ks < 8; ++ks)
#pragma unroll
        for (int mt = 0; mt < 2; ++mt) St[mt] = mfma32(lds8(Ks + ((32 * mt + l31) * 136 + 16 * ks + 8 * hh) * 2), Qf[ks], St[mt]);
      if (kt == 0 || kt == 4) {
#pragma unroll
        for (int mt = 0; mt < 2; ++mt)
#pragma unroll
          for (int r = 0; r < 16; ++r) {
            const int key = key0 + 32 * mt + (r & 3) + 8 * (r >> 2) + 4 * hh, dlt = key - qpos;
            const float pv = (dlt <= 128 && dlt >= -128) ? __builtin_amdgcn_exp2f(St[mt][r] - shift) : 0.f;
            lsum += pv; St[mt][r] = pv;
          }
      } else {
#pragma unroll
        for (int mt = 0; mt < 2; ++mt)
#pragma unroll
          for (int r = 0; r < 16; ++r) { const float pv = __builtin_amdgcn_exp2f(St[mt][r] - shift); lsum += pv; St[mt][r] = pv; }
      }
#pragma unroll
      for (int mt = 0; mt < 2; ++mt)
#pragma unroll
        for (int g4 = 0; g4 < 4; ++g4) {
          u32x2 w; w.x = pk2(St[mt][4 * g4], St[mt][4 * g4 + 1]); w.y = pk2(St[mt][4 * g4 + 2], St[mt][4 * g4 + 3]);
          *(LAS u32x2*)(Pw + (l31 * 72 + 32 * mt + 8 * g4 + 4 * hh) * 2) = w;
        }
#pragma unroll
      for (int ks = 0; ks < 4; ++ks) {
        const bf16x8 a = lds8(Pw + (l31 * 72 + 16 * ks + 8 * hh) * 2);
        const unsigned vbase = (unsigned)(size_t)Vs + (unsigned)(((16 * ks + 8 * hh + ((lane & 15) >> 2)) * 136 + 16 * ((lane >> 4) & 1) + 4 * (lane & 3)) * 2);
        u16x4 tr[8];
        TR_READ8(tr, vbase, 0, 1088, 64, 1152, 128, 1216, 192, 1280);
#pragma unroll
        for (int nt = 0; nt < 4; ++nt) O[nt] = mfma32(a, tr_join(tr[2 * nt], tr[2 * nt + 1]), O[nt]);
      }
      if (kt < kt_hi) {
        LAS unsigned char* Kn = lds + ((kt + 1 - kt_lo) & 1) * 34816;
#pragma unroll
        for (int i = 0; i < 2; ++i) { *(LAS u32x4*)(Kn + ((kr_ + i * 32) * 136 + kc8) * 2) = kreg[i]; *(LAS u32x4*)(Kn + 17408 + ((kr_ + i * 32) * 136 + kc8) * 2) = vreg[i]; }
        if (kt + 1 < kt_hi) {
#pragma unroll
          for (int i = 0; i < 2; ++i) { kreg[i] = *(const u32x4*)(kgp + (long)((kt + 2) * 64 + i * 32) * (long)kINW); vreg[i] = *(const u32x4*)(vgp + (long)((kt + 2) * 64 + i * 32) * (long)kINW); }
        }
      }
      __syncthreads();
    }
    lsum += __shfl_xor(lsum, 32);
    const float denom = lsum + exp2f(sk - shift);
    if (lane < 32) Dn[lane] = 1.0f / denom;
#pragma unroll
    for (int g4 = 0; g4 < 4; ++g4) {
      const f32x4 inv4 = *(LAS f32x4*)(Dn + 8 * g4 + 4 * hh);
      bf16_t gts[4][4];
#pragma unroll
      for (int j = 0; j < 4; ++j)
#pragma unroll
        for (int nt = 0; nt < 4; ++nt) gts[j][nt] = Z[(size_t)(b * 2048 + q0 + 8 * g4 + 4 * hh + j) * kINW + ZC_AG + hq * 128 + 32 * nt + l31];
#pragma unroll
      for (int j = 0; j < 4; ++j)
#pragma unroll
        for (int nt = 0; nt < 4; ++nt)
          YC[(size_t)(b * 2048 + q0 + 8 * g4 + 4 * hh + j) * 2048 + 512 + hq * 128 + 32 * nt + l31] = (bf16_t)f2bf(O[nt][4 * g4 + j] * inv4[j] * bf2f(gts[j][nt]));
    }
  }
}

__device__ __forceinline__ void retstate_phase(const Params& p, LAS unsigned char* lds, int tid, int G) {
  const int lane = tid & 63, wave = tid >> 6, l31 = lane & 31, hh = lane >> 5;
  const bf16_t* Z = (const bf16_t*)(p.ws + WS_Z);
  const int er = wave >> 2, dc = wave & 3;
  const int sr = tid >> 4, sc8 = (tid & 15) * 8;
  const int vr = tid >> 3, vc8 = (tid & 7) * 8;
  const int trq = (lane & 15) >> 2, trb = (lane >> 4) & 1, trp = lane & 3;
  for (int unit = blockIdx.x; unit < 256; unit += G) {
    const int eh = unit & 1, dir = (unit >> 1) & 1, h = (unit >> 2) & 3, b = unit >> 4;
    const float lg = lgam2(h);
    const float gch = exp2f(128.0f * lg);
    const bf16_t* kb = Z + ((size_t)b * 2048 + sr) * kINW + ZC_RK + h * 128 + sc8;
    const bf16_t* vb = Z + ((size_t)b * 2048 + vr) * kINW + ZC_RV + h * 128 + 64 * eh + vc8;
    bf16_t* S = (bf16_t*)(p.ws + (dir ? WS_SF : WS_SP));
    const int e = 64 * eh + 32 * er + l31;
    float wk[4];
#pragma unroll
    for (int i = 0; i < 4; ++i) { const int j = sr + 32 * i; wk[i] = exp2f(lg * (float)(dir ? j : 127 - j)); }
    f32x16 acc = zero16();
    u32x4 r0k[4], r0v[2], r1k[4], r1v[2];
#define RS_LOAD(RK, RV, ST) do { const int n_ = dir ? 15 - (ST) : (ST); \
      _Pragma("unroll") for (int i = 0; i < 4; ++i) RK[i] = *(const u32x4*)(kb + (size_t)(n_ * 128 + i * 32) * kINW); \
      _Pragma("unroll") for (int i = 0; i < 2; ++i) RV[i] = *(const u32x4*)(vb + (size_t)(n_ * 128 + i * 64) * kINW); } while (0)
#define RS_STEP(RK, RV, BUF, ST) do { \
      LAS unsigned char* Kt = lds + (BUF) * 69632; LAS unsigned char* Vt = Kt + 34816; \
      _Pragma("unroll") for (int i = 0; i < 4; ++i) { float f_[8]; unpack8(RK[i], f_); _Pragma("unroll") for (int j = 0; j < 8; ++j) f_[j] *= wk[i]; \
        *(LAS u32x4*)(Kt + ((sr + 32 * i) * 136 + sc8) * 2) = pack8(f_); } \
      _Pragma("unroll") for (int i = 0; i < 2; ++i) *(LAS u32x4*)(Vt + ((vr + 64 * i) * 136 + vc8) * 2) = RV[i]; \
      __syncthreads(); \
      if ((ST) + 2 < 16) RS_LOAD(RK, RV, (ST) + 2); \
      const int n = dir ? 15 - (ST) : (ST); \
      bf16_t* so = S + (((size_t)(b * 4 + h) * 16 + n) * 128 + e) * 128 + 32 * dc + 4 * hh; \
      _Pragma("unroll") for (int g4 = 0; g4 < 4; ++g4) { u32x2 w; w.x = pk2(acc[4 * g4], acc[4 * g4 + 1]); w.y = pk2(acc[4 * g4 + 2], acc[4 * g4 + 3]); *(u32x2*)(so + 8 * g4) = w; } \
      _Pragma("unroll") for (int r = 0; r < 16; ++r) acc[r] *= gch; \
      const unsigned ka_ = (unsigned)(size_t)Kt + (unsigned)(((8 * hh + trq) * 136 + 32 * dc + 16 * trb + 4 * trp) * 2); \
      const unsigned va_ = (unsigned)(size_t)Vt + (unsigned)(((8 * hh + trq) * 136 + 32 * er + 16 * trb + 4 * trp) * 2); \
      _Pragma("unroll") for (int k4 = 0; k4 < 2; ++k4) { u16x4 ta[8], tb[8]; \
        TR_READ8(ta, ka_ + k4 * 17408, 0, 1088, 4352, 5440, 8704, 9792, 13056, 14144); \
        TR_READ8(tb, va_ + k4 * 17408, 0, 1088, 4352, 5440, 8704, 9792, 13056, 14144); \
        _Pragma("unroll") for (int ks = 0; ks < 4; ++ks) acc = mfma32(tr_join(ta[2 * ks], ta[2 * ks + 1]), tr_join(tb[2 * ks], tb[2 * ks + 1]), acc); } } while (0)
    RS_LOAD(r0k, r0v, 0); RS_LOAD(r1k, r1v, 1);
    __syncthreads();
#pragma unroll 1
    for (int st = 0; st < 16; st += 2) { RS_STEP(r0k, r0v, 0, st); RS_STEP(r1k, r1v, 1, st + 1); }
#undef RS_STEP
#undef RS_LOAD
  }
}

__device__ __forceinline__ void retout_phase(const Params& p, int l, LAS unsigned char* lds, int tid, int G) {
  const int lane = tid & 63, wave = tid >> 6, l31 = lane & 31, hh = lane >> 5;
  const bf16_t* Z = (const bf16_t*)(p.ws + WS_Z);
  const bf16_t* RVT = (const bf16_t*)(p.ws + WS_RVT);
  const bf16_t* SP = (const bf16_t*)(p.ws + WS_SP); const bf16_t* SF = (const bf16_t*)(p.ws + WS_SF);
  bf16_t* YC = (bf16_t*)(p.ws + WS_H);
  const float* gnw = p.in[21] + l * 512;
  LAS unsigned char* R0 = lds;
  LAS unsigned char* R1 = lds + 34816;
  LAS unsigned char* R2 = lds + 69632;
  LAS unsigned char* R3 = lds + 104448;
  LAS float* Of = (LAS float*)lds;
  const int ri = wave >> 1, hf = wave & 1;
  const int sr = tid >> 4, sc8 = (tid & 15) * 8;
  for (int unit = blockIdx.x; unit < 1024; unit += G) {
    const int h = unit & 3, n = (unit >> 2) & 15, b = unit >> 6;
    const size_t tokb = (size_t)b * 2048 + n * 128;
    const float lg2 = lgam2(h);
    u32x4 tq[4], tk[4], tv[4], tp[4], tf[4];
#pragma unroll
    for (int i = 0; i < 4; ++i) {
      const int row = sr + 32 * i;
      tq[i] = *(const u32x4*)(Z + (tokb + row) * kINW + ZC_RQ + h * 128 + sc8);
      tk[i] = *(const u32x4*)(Z + (tokb + row) * kINW + ZC_RK + h * 128 + sc8);
      tv[i] = *(const u32x4*)(Z + (tokb + row) * kINW + ZC_RV + h * 128 + sc8);
    }
    __syncthreads();
#pragma unroll
    for (int i = 0; i < 4; ++i) {
      const int off = ((sr + 32 * i) * 136 + sc8) * 2;
      *(LAS u32x4*)(R0 + off) = tq[i]; *(LAS u32x4*)(R1 + off) = tk[i]; *(LAS u32x4*)(R3 + off) = tv[i];
    }
#pragma unroll
    for (int i = 0; i < 4; ++i) {
      const int row = sr + 32 * i;
      tp[i] = *(const u32x4*)(SP + (((size_t)(b * 4 + h) * 16 + n) * 128 + row) * 128 + sc8);
      tf[i] = *(const u32x4*)(SF + (((size_t)(b * 4 + h) * 16 + n) * 128 + row) * 128 + sc8);
    }
    __syncthreads();
    const int iq = 32 * ri + l31;
    bf16x8 Qf[8];
#pragma unroll
    for (int ks = 0; ks < 8; ++ks) Qf[ks] = lds8(R0 + (iq * 136 + 16 * ks + 8 * hh) * 2);
#pragma unroll
    for (int mt = 0; mt < 2; ++mt) {
      f32x16 acc = zero16();
#pragma unroll
      for (int ks = 0; ks < 8; ++ks) acc = mfma32(lds8(R1 + ((64 * hf + 32 * mt + l31) * 136 + 16 * ks + 8 * hh) * 2), Qf[ks], acc);
#pragma unroll
      for (int g4 = 0; g4 < 4; ++g4) {
        const int j0 = 64 * hf + 32 * mt + 8 * g4 + 4 * hh;
        float v[4];
#pragma unroll
        for (int jj = 0; jj < 4; ++jj) { const int dl = iq - (j0 + jj); v[jj] = acc[4 * g4 + jj] * __builtin_amdgcn_exp2f(lg2 * (float)(dl < 0 ? -dl : dl)); }
        u32x2 w; w.x = pk2(v[0], v[1]); w.y = pk2(v[2], v[3]);
        *(LAS u32x2*)(R2 + (iq * 136 + j0) * 2) = w;
      }
    }
    __syncthreads();
#pragma unroll
    for (int i = 0; i < 4; ++i) *(LAS u32x4*)(R1 + ((sr + 32 * i) * 136 + sc8) * 2) = tp[i];
    __syncthreads();
    f32x16 acc[2]; acc[0] = zero16(); acc[1] = zero16();
#pragma unroll
    for (int nt = 0; nt < 2; ++nt)
#pragma unroll
      for (int ks = 0; ks < 8; ++ks) acc[nt] = mfma32(Qf[ks], lds8(R1 + ((64 * hf + 32 * nt + l31) * 136 + 16 * ks + 8 * hh) * 2), acc[nt]);
#pragma unroll
    for (int r = 0; r < 16; ++r) {
      const int il = 32 * ri + (r & 3) + 8 * (r >> 2) + 4 * hh;
      const float rt = exp2f(lg2 * (float)(2 * il + 1 - 128));
      acc[0][r] *= rt; acc[1][r] *= rt;
    }
    __syncthreads();
#pragma unroll
    for (int i = 0; i < 4; ++i) *(LAS u32x4*)(R1 + ((sr + 32 * i) * 136 + sc8) * 2) = tf[i];
    __syncthreads();
#pragma unroll
    for (int nt = 0; nt < 2; ++nt)
#pragma unroll
      for (int ks = 0; ks < 8; ++ks) acc[nt] = mfma32(Qf[ks], lds8(R1 + ((64 * hf + 32 * nt + l31) * 136 + 16 * ks + 8 * hh) * 2), acc[nt]);
#pragma unroll
    for (int r = 0; r < 16; ++r) {
      const int il = 32 * ri + (r & 3) + 8 * (r >> 2) + 4 * hh;
      const float fw = exp2f(lg2 * (float)(128 - il));
      acc[0][r] *= fw; acc[1][r] *= fw;
    }
#pragma unroll
    for (int m2 = 0; m2 < 4; ++m2) {
      const unsigned vbase = (unsigned)(size_t)R3 + (unsigned)(((32 * m2 + 8 * hh + ((lane & 15) >> 2)) * 136 + 64 * hf + 16 * ((lane >> 4) & 1) + 4 * (lane & 3)) * 2);
      u16x4 tr[8];
      TR_READ8(tr, vbase, 0, 1088, 64, 1152, 4352, 5440, 4416, 5504);
#pragma unroll
      for (int k2 = 0; k2 < 2; ++k2) {
        const bf16x8 a = lds8(R2 + (iq * 136 + 16 * (2 * m2 + k2) + 8 * hh) * 2);
#pragma unroll
        for (int nt = 0; nt < 2; ++nt) acc[nt] = mfma32(a, tr_join(tr[4 * k2 + 2 * nt], tr[4 * k2 + 2 * nt + 1]), acc[nt]);
      }
    }
    __syncthreads();
#pragma unroll
    for (int nt = 0; nt < 2; ++nt)
#pragma unroll
      for (int r = 0; r < 16; ++r) Of[(32 * ri + (r & 3) + 8 * (r >> 2) + 4 * hh) * 132 + 64 * hf + 32 * nt + l31] = acc[nt][r];
    __syncthreads();
    {
      const int c = lane & 15, rs4 = lane >> 4;
      float wn[8];
      { const f32x4 a = *(const f32x4*)(gnw + h * 128 + 8 * c), bq = *(const f32x4*)(gnw + h * 128 + 8 * c + 4);
        wn[0] = a[0]; wn[1] = a[1]; wn[2] = a[2]; wn[3] = a[3]; wn[4] = bq[0]; wn[5] = bq[1]; wn[6] = bq[2]; wn[7] = bq[3]; }
      u32x4 gv[4], ov[4];
#pragma unroll
      for (int ps = 0; ps < 4; ++ps) gv[ps] = *(const u32x4*)(Z + (tokb + 16 * wave + 4 * ps + rs4) * kINW + ZC_RG + h * 128 + 8 * c);
#pragma unroll
      for (int ps = 0; ps < 4; ++ps) {
        const int row = 16 * wave + 4 * ps + rs4;
        const f32x4 x0 = *(const LAS f32x4*)(Of + row * 132 + 8 * c), x1 = *(const LAS f32x4*)(Of + row * 132 + 8 * c + 4);
        float f[8] = {x0[0], x0[1], x0[2], x0[3], x1[0], x1[1], x1[2], x1[3]};
        float sm = 0.f;
#pragma unroll
        for (int j = 0; j < 8; ++j) sm += f[j];
        sm += __shfl_xor(sm, 1); sm += __shfl_xor(sm, 2); sm += __shfl_xor(sm, 4); sm += __shfl_xor(sm, 8);
        const float mu = sm * (1.0f / 128.0f);
        float vs = 0.f;
#pragma unroll
        for (int j = 0; j < 8; ++j) { f[j] -= mu; vs += f[j] * f[j]; }
        vs += __shfl_xor(vs, 1); vs += __shfl_xor(vs, 2); vs += __shfl_xor(vs, 4); vs += __shfl_xor(vs, 8);
        const float rs = rsqrtf(vs * (1.0f / 128.0f) + 1e-6f);
        float fg[8]; unpack8(gv[ps], fg);
#pragma unroll
        for (int j = 0; j < 8; ++j) f[j] = f[j] * rs * wn[j] * fg[j];
        ov[ps] = pack8(f);
      }
#pragma unroll
      for (int ps = 0; ps < 4; ++ps) *(u32x4*)(YC + (tokb + 16 * wave + 4 * ps + rs4) * 2048 + 1536 + h * 128 + 8 * c) = ov[ps];
    }
  }
}

__device__ __forceinline__ void s5_phase(const Params& p, int l, LAS unsigned char* lds, int tid, int G) {
  const int lane = tid & 63, wave = tid >> 6, l31 = lane & 31, hh = lane >> 5;
  const bf16_t* Z = (const bf16_t*)(p.ws + WS_Z);
  bf16_t* YS = (bf16_t*)(p.ws + WS_YS);
  LAS unsigned char* Us = lds;
  LAS float* Hc = (LAS float*)(lds + 67584);
  for (int unit = blockIdx.x; unit < 512; unit += G) {
    const int g = unit & 31, b = unit >> 5;
    const bf16_t* EEp = (const bf16_t*)(p.ws + WS_EE) + (size_t)(l * 32 + g) * 65536;
    const bf16_t* MFp = (const bf16_t*)(p.ws + WS_MF) + (size_t)(l * 32 + g) * 131072;
    const bf16_t* mrow = MFp + (32 * wave + l31) * 512 + 8 * hh;
    __syncthreads();
    {
      u32x4 uv[8];
#pragma unroll
      for (int i = 0; i < 8; ++i) { const int idx = tid + 512 * i, tok = idx >> 1, half = idx & 1; uv[i] = *(const u32x4*)(Z + (size_t)(b * 2048 + tok) * kINW + g * 16 + half * 8); }
#pragma unroll
      for (int i = 0; i < 8; ++i) { const int idx = tid + 512 * i, tok = idx >> 1, half = idx & 1; *(LAS u32x4*)(Us + (tok >> 4) * 528 + (tok & 15) * 32 + half * 16) = uv[i]; }
    }
    __syncthreads();
    f32x16 acc[4];
#pragma unroll
    for (int nt = 0; nt < 4; ++nt) acc[nt] = zero16();
#pragma unroll 1
    for (int dir = 0; dir < 2; ++dir) {
      {
        const int rt = wave >> 1, ct0 = (wave & 1) * 2;
        f32x16 a2[2]; a2[0] = zero16(); a2[1] = zero16();
        const bf16_t* arow = EEp + (dir * 128 + 32 * rt + l31) * 256 + 8 * hh;
#pragma unroll
        for (int ks = 0; ks < 16; ++ks) {
          const bf16x8 a = ldg8(arow + 16 * ks);
#pragma unroll
          for (int t2 = 0; t2 < 2; ++t2) a2[t2] = mfma32(a, lds8(Us + (32 * (ct0 + t2) + l31) * 528 + ks * 32 + hh * 16), a2[t2]);
        }
#pragma unroll
        for (int t2 = 0; t2 < 2; ++t2)
#pragma unroll
          for (int g4 = 0; g4 < 4; ++g4) {
            f32x4 v; v[0] = a2[t2][4 * g4]; v[1] = a2[t2][4 * g4 + 1]; v[2] = a2[t2][4 * g4 + 2]; v[3] = a2[t2][4 * g4 + 3];
            *(LAS f32x4*)(Hc + (32 * (ct0 + t2) + l31) * 132 + 32 * rt + 8 * g4 + 4 * hh) = v;
          }
      }
      __syncthreads();
      if (wave == 0) {
        const float* a16 = (const float*)(p.ws + WS_A16) + ((size_t)((l * 32 + g) * 2 + dir) * 64 + lane) * 2;
        const float ar = a16[0], ai = a16[1];
        float cr = 0.f, ci = 0.f;
        for (int c8 = 0; c8 < 16; ++c8) {
          float hr[8], hi[8];
#pragma unroll
          for (int j = 0; j < 8; ++j) { const int c = dir ? 127 - (c8 * 8 + j) : c8 * 8 + j; hr[j] = Hc[c * 132 + lane]; hi[j] = Hc[c * 132 + 64 + lane]; }
#pragma unroll
          for (int j = 0; j < 8; ++j) {
            const int c = dir ? 127 - (c8 * 8 + j) : c8 * 8 + j;
            Hc[c * 132 + lane] = cr; Hc[c * 132 + 64 + lane] = ci;
            const float nr = ar * cr - ai * ci + hr[j], ni = ar * ci + ai * cr + hi[j];
            cr = nr; ci = ni;
          }
        }
      }
      if (dir == 0) {
        for (int ks = 0; ks < 16; ++ks) {
          const bf16x8 a = ldg8(mrow + 16 * ks);
#pragma unroll
          for (int nt = 0; nt < 4; ++nt) acc[nt] = mfma32(a, lds8(Us + (32 * nt + l31) * 528 + ks * 32 + hh * 16), acc[nt]);
        }
      }
      __syncthreads();
      for (int ks = 0; ks < 8; ++ks) {
        const bf16x8 a = ldg8(mrow + 256 + dir * 128 + 16 * ks);
#pragma unroll
        for (int nt = 0; nt < 4; ++nt) {
          const LAS float* cp = Hc + (32 * nt + l31) * 132 + 16 * ks + 8 * hh;
          const f32x4 c0 = *(const LAS f32x4*)cp, c1 = *(const LAS f32x4*)(cp + 4);
          u32x4 w; w.x = pk2(c0[0], c0[1]); w.y = pk2(c0[2], c0[3]); w.z = pk2(c1[0], c1[1]); w.w = pk2(c1[2], c1[3]);
          acc[nt] = mfma32(a, __builtin_bit_cast(bf16x8, w), acc[nt]);
        }
      }
      __syncthreads();
    }
#pragma unroll
    for (int nt = 0; nt < 4; ++nt)
#pragma unroll
      for (int g4 = 0; g4 < 4; ++g4) {
        const int row0 = 32 * wave + 8 * g4 + 4 * hh, i = row0 >> 4, p0 = row0 & 15, c = 32 * nt + l31;
        const size_t tok = (size_t)b * 2048 + 16 * c + i;
        u32x2 w; w.x = pk2(gelu_tanh_f(acc[nt][4 * g4]), gelu_tanh_f(acc[nt][4 * g4 + 1])); w.y = pk2(gelu_tanh_f(acc[nt][4 * g4 + 2]), gelu_tanh_f(acc[nt][4 * g4 + 3]));
        *(u32x2*)(YS + tok * 512 + g * 16 + p0) = w;
      }
  }
}

extern __shared__ __attribute__((aligned(16))) unsigned char dyn_lds[];
__global__ void __launch_bounds__(512, 2) mega(Params p) {
  cg::grid_group grid = cg::this_grid();
  LAS unsigned char* lds = (LAS unsigned char*)dyn_lds;
  volatile LAS unsigned* bst = (volatile LAS unsigned*)(lds + kLdsBytes - 64);
  if (threadIdx.x < 16) bst[threadIdx.x] = 0u;
  __syncthreads();
  (void)xcd_barrier_post((unsigned*)(p.ws + WS_CTL), bst);
#define GSYNC() do { XcdBarrier xb_; xb_.bar = (unsigned*)(p.ws + WS_CTL); xb_.x = xb_xcc_id(); xb_.st = bst; xcd_barrier(xb_); } while (0)
  const int G = gridDim.x;
#define tid opaque_tid()
#define WSL() ({ Params q_ = p; __attribute__((address_space(1))) unsigned char* g_ = (__attribute__((address_space(1))) unsigned char*)q_.ws; asm volatile("" : "+s"(g_)); q_.ws = (unsigned char*)g_; q_; })
#ifndef PHMASK
#define PHMASK 0xFFFF
#endif
#ifndef REPMASK
#define REPMASK 0
#endif
#ifndef XSYNC
#define XSYNC 0
#endif
#if PHMASK & 1
  phase0(WSL(), lds, tid, G);
#if REPMASK & 1
  phase0(WSL(), lds, tid, G);
#endif
#endif
  if (p.ws == nullptr) grid.sync();
  GSYNC();
  for (int l = 0; l < 2; ++l) {
    const float* xin = l == 0 ? p.in[0] : p.out;
#if PHMASK & 2
    norm_phase(WSL(), l, xin, lds, tid, G);
#if REPMASK & 2
    norm_phase(WSL(), l, xin, lds, tid, G);
#endif
#endif
    GSYNC();
#if PHMASK & 4
    {
      const Params q = WSL();
      pg8::Gemm g{(const bf16_t*)(q.ws + WS_H), (const bf16_t*)(q.ws + WS_WIN) + (size_t)l * 5632 * 2048, kT, kINW, 2048};
      pg8::StaticOrder S; S.init(kT, kINW, G, (int)blockIdx.x);
      EpiZ E{(bf16_t*)(q.ws + WS_Z)};
      pg8::gemm_phase<EpiZ, pg8::StaticOrder, true, true>(lds, g, S, E);
#if REPMASK & 4
      pg8::gemm_phase<EpiZ, pg8::StaticOrder, true, true>(lds, g, S, E);
#endif
    }
#endif
    GSYNC();
#if PHMASK & 8
    prep_phase(WSL(), l, lds, tid, G);
#endif
    GSYNC();
#if PHMASK & 16
    attn_phase(WSL(), l, lds, tid, G);
#if REPMASK & 16
    attn_phase(WSL(), l, lds, tid, G);
#endif
#endif
#if PHMASK & 32
    retstate_phase(WSL(), lds, tid, G);
#if REPMASK & 32
    retstate_phase(WSL(), lds, tid, G);
#endif
#endif
#if PHMASK & 64
    s5_phase(WSL(), l, lds, tid, G);
#if REPMASK & 64
    s5_phase(WSL(), l, lds, tid, G);
#endif
#endif
    GSYNC();
#if PHMASK & 256
    {
      const Params q = WSL();
      pg8::Gemm g{(const bf16_t*)(q.ws + WS_YS), (const bf16_t*)(q.ws + WS_GLU) + (size_t)l * 512 * 512, kT, 512, 512};
      pg8::StaticOrder S; S.init(kT, 512, G, (int)blockIdx.x);
      EpiGlu E{(const bf16_t*)(q.ws + WS_YS), (const bf16_t*)(q.ws + WS_Z), q.in[17] + l * 512, (bf16_t*)(q.ws + WS_H)};
      __syncthreads();
      pg8::gemm_phase<EpiGlu, pg8::StaticOrder, true, true>(lds, g, S, E);
#if REPMASK & 256
      pg8::gemm_phase<EpiGlu, pg8::StaticOrder, true, true>(lds, g, S, E);
#endif
    }
#endif
    __syncthreads();
#if PHMASK & 512
    retout_phase(WSL(), l, lds, tid, G);
#if REPMASK & 512
    retout_phase(WSL(), l, lds, tid, G);
#endif
#endif
    GSYNC();
#if PHMASK & 1024
    {
      const Params q = WSL();
      pg8::Gemm g{(const bf16_t*)(q.ws + WS_H), (const bf16_t*)(q.ws + WS_WOUT) + (size_t)l * 2048 * 2048, kT, 2048, 2048};
      pg8::StaticOrder S; S.init(kT, 2048, G, (int)blockIdx.x);
      EpiOut E{xin, q.out, (const float*)(q.ws + WS_ADA) + (size_t)l * 16 * 6144 + 4096};
      __syncthreads();
      pg8::gemm_phase<EpiOut, pg8::StaticOrder, true, true>(lds, g, S, E);
#if REPMASK & 1024
      if (l == 0) pg8::gemm_phase<EpiOut, pg8::StaticOrder, true, true>(lds, g, S, E);
#endif
    }
#endif
    GSYNC();
    for (int xs = 0; xs < XSYNC; ++xs) GSYNC();
  }
#undef tid
#undef WSL
}

extern "C" void kernel_launch(void* const* d_in, const int* in_sizes, int n_in, void* d_out, int out_size, void* d_ws, size_t ws_size, hipStream_t stream) {
  static int grid_blocks = 0;
  if (grid_blocks == 0) {
    if (n_in != 22 || ws_size < WS_END) { fprintf(stderr, "kernel_launch: unexpected n_in %d or ws_size %zu (need %zu)\n", n_in, ws_size, (size_t)WS_END); grid_blocks = -1; return; }
    int dev = 0, cus = 0, per_cu = 0;
    (void)hipGetDevice(&dev);
    (void)hipDeviceGetAttribute(&cus, hipDeviceAttributeMultiprocessorCount, dev);
    (void)hipFuncSetAttribute((const void*)mega, hipFuncAttributeMaxDynamicSharedMemorySize, kLdsBytes);
    (void)hipOccupancyMaxActiveBlocksPerMultiprocessor(&per_cu, (const void*)mega, 512, kLdsBytes);
    if (per_cu < 1) fprintf(stderr, "kernel_launch: occupancy query says %d blocks per CU\n", per_cu);
    (void)hipGetLastError();
    grid_blocks = 256;
    while (grid_blocks > cus) grid_blocks >>= 1;
  }
  if (grid_blocks < 0) return;
  (void)hipMemsetAsync((unsigned char*)d_ws + WS_CTL, 0, CTL_BYTES, stream);
  Params p{};
  for (int i = 0; i < 22; ++i) p.in[i] = (const float*)d_in[i];
  p.out = (float*)d_out; p.ws = (unsigned char*)d_ws;
  void* args[] = {&p};
  hipError_t e = hipLaunchCooperativeKernel((void*)mega, dim3(grid_blocks), dim3(512), args, kLdsBytes, stream);
  if (e != hipSuccess) fprintf(stderr, "cooperative launch failed: %s (grid %d)\n", hipGetErrorString(e), grid_blocks);
}
```
